# Optimizing an MI355X kernel written in HIP

```python
import math
import jax, jax.numpy as jnp
from jax import lax
import numpy as np

D_MODEL = 2048
BATCH = 4
SEQ = 4096
DEPTH = 2

D_MIX = D_MODEL
HEAD_DIM = 64
N_Q_HEADS = 16
N_KV_HEADS = 4
GQ = N_Q_HEADS // N_KV_HEADS
WINDOW = 128
ATTN_BLOCK = 128
ROT_DIM = HEAD_DIM // 4
ROPE_THETA = 500000.0
CONV_GROUPS = 8
CONV_CH = CONV_GROUPS * HEAD_DIM
CONV_WIDTH = 31
SGU_HEADS = 8
SGU_CH = SGU_HEADS * HEAD_DIM
SGU_CHUNK = 128
D_FF = 5632
FFN_RESIDUAL_WEIGHT = 0.5
NORM_EPS = 1e-5

Q_END = N_Q_HEADS * HEAD_DIM
K_END = Q_END + N_KV_HEADS * HEAD_DIM
V_END = K_END + N_KV_HEADS * HEAD_DIM
CONV_END = V_END + 2 * CONV_CH
IN_COLS = CONV_END + 2 * SGU_CH

kernel_name = 'hybrid_parallel_conv_sgu_swa_block'


def rms_norm(x, g):
    xf = x.astype(jnp.float32)
    y = xf * lax.rsqrt(jnp.mean(xf * xf, axis=-1, keepdims=True) + NORM_EPS)
    return (y * g.astype(jnp.float32)).astype(x.dtype)


def layer_norm(x, g, b):
    xf = x.astype(jnp.float32)
    mu = jnp.mean(xf, axis=-1, keepdims=True)
    xc = xf - mu
    y = xc * lax.rsqrt(jnp.mean(xc * xc, axis=-1, keepdims=True) + NORM_EPS)
    return (y * g.astype(jnp.float32) + b.astype(jnp.float32)).astype(x.dtype)


def swiglu(h, w_in, w_out):
    gu = h @ w_in
    return (jax.nn.silu(gu[..., :D_FF]) * gu[..., D_FF:]) @ w_out


def rope_tables(positions):
    inv_freq = 1.0 / (ROPE_THETA ** (jnp.arange(0, ROT_DIM, 2, dtype=jnp.float32) / ROT_DIM))
    ang = positions.astype(jnp.float32)[..., None] * inv_freq
    return jnp.cos(ang), jnp.sin(ang)


def apply_partial_rope(t, cos, sin):
    half = ROT_DIM // 2
    t1 = t[..., :half].astype(jnp.float32)
    t2 = t[..., half:ROT_DIM].astype(jnp.float32)
    c = cos[:, :, None, :]
    s = sin[:, :, None, :]
    rot = jnp.concatenate([t1 * c - t2 * s, t2 * c + t1 * s], axis=-1).astype(t.dtype)
    return jnp.concatenate([rot, t[..., ROT_DIM:]], axis=-1)


def sliding_window_attention(q, k, v, sinks):
    B, S = q.shape[0], q.shape[1]
    nb = S // ATTN_BLOCK
    qb = q.reshape(B, nb, ATTN_BLOCK, N_KV_HEADS, GQ, HEAD_DIM)

    def with_prev(t):
        tb = t.reshape(B, nb, ATTN_BLOCK, N_KV_HEADS, HEAD_DIM)
        prev = jnp.concatenate([jnp.zeros_like(tb[:, :1]), tb[:, :-1]], axis=1)
        return jnp.concatenate([prev, tb], axis=2)

    kk, vv = with_prev(k), with_prev(v)
    scores = jnp.einsum('bnqhgd,bnkhd->bnhgqk', qb, kk).astype(jnp.float32) * (HEAD_DIM ** -0.5)
    qi = jnp.arange(ATTN_BLOCK)[:, None]
    kj = jnp.arange(2 * ATTN_BLOCK)[None, :]
    dist = qi + ATTN_BLOCK - kj
    band = (dist >= 0) & (dist < WINDOW)
    kpos = jnp.arange(nb)[:, None, None] * ATTN_BLOCK + kj[None] - ATTN_BLOCK
    mask = band[None] & (kpos >= 0)
    scores = jnp.where(mask[None, :, None, None], scores, jnp.float32(-1e30))
    s = sinks.astype(jnp.float32).reshape(N_KV_HEADS, GQ)[None, None, :, :, None, None]
    m = jnp.maximum(jnp.max(scores, axis=-1, keepdims=True), s)
    p = jnp.exp(scores - m)
    p = p / (jnp.sum(p, axis=-1, keepdims=True) + jnp.exp(s - m))
    out = jnp.einsum('bnhgqk,bnkhd->bnqhgd', p.astype(v.dtype), vv)
    return out.reshape(B, S, N_Q_HEADS * HEAD_DIM)


def conv_module(a, dw_w, dw_b, ln_g, ln_b):
    h = a[..., :CONV_CH] * jax.nn.sigmoid(a[..., CONV_CH:])
    hp = jnp.pad(h, ((0, 0), (CONV_WIDTH - 1, 0), (0, 0)))
    y = lax.conv_general_dilated(hp, dw_w[:, None, :].astype(h.dtype), window_strides=(1,),
                                 padding='VALID', dimension_numbers=('NWC', 'WIO', 'NWC'),
                                 feature_group_count=CONV_CH) + dw_b
    return jax.nn.silu(layer_norm(y, ln_g, ln_b))


def spatial_gating(a, ln_g, ln_b, w_s, b_s):
    B, S = a.shape[0], a.shape[1]
    u = a[..., :SGU_CH]
    v = layer_norm(a[..., SGU_CH:], ln_g, ln_b)
    vb = v.reshape(B, S // SGU_CHUNK, SGU_CHUNK, SGU_HEADS, HEAD_DIM)
    causal = jnp.tril(jnp.ones((SGU_CHUNK, SGU_CHUNK), dtype=bool))
    ws = jnp.where(causal[None], w_s, jnp.zeros_like(w_s))
    mixed = jnp.einsum('hts,bnshd->bnthd', ws, vb) + b_s.T[None, None, :, :, None]
    return u * mixed.reshape(B, S, SGU_CH)


def setup_inputs(seed: int = 0) -> dict:
    key = jax.random.key(seed)
    ks = jax.random.split(key, 24)
    L, D, F = DEPTH, D_MODEL, D_FF
    nrm = lambda k, shape, scale: jax.random.normal(k, shape, jnp.float32) * scale
    gain = lambda k, shape: 1.0 + 0.05 * jax.random.normal(k, shape, jnp.float32)
    x = jax.random.normal(ks[0], (BATCH, SEQ, D), jnp.float32)
    offs = jax.random.randint(ks[1], (BATCH, 1), 0, 1024, dtype=jnp.int32)
    positions = (jnp.arange(SEQ, dtype=jnp.int32)[None, :] + offs).astype(jnp.int32)
    return {
        'x': x,
        'positions': positions,
        'norm_ffn1': gain(ks[2], (L, D)),
        'ffn1_w_in': nrm(ks[3], (L, D, 2 * F), D ** -0.5),
        'ffn1_w_out': nrm(ks[4], (L, F, D), F ** -0.5),
        'norm_mix': gain(ks[5], (L, D)),
        'w_in': nrm(ks[6], (L, D, IN_COLS), D ** -0.5),
        'conv_dw_w': nrm(ks[7], (L, CONV_WIDTH, CONV_CH), CONV_WIDTH ** -0.5),
        'conv_dw_b': nrm(ks[8], (L, CONV_CH), 0.02),
        'conv_ln_g': gain(ks[9], (L, CONV_CH)),
        'conv_ln_b': nrm(ks[10], (L, CONV_CH), 0.02),
        'sgu_ln_g': gain(ks[11], (L, SGU_CH)),
        'sgu_ln_b': nrm(ks[12], (L, SGU_CH), 0.02),
        'sgu_w': nrm(ks[13], (L, SGU_HEADS, SGU_CHUNK, SGU_CHUNK), SGU_CHUNK ** -0.5),
        'sgu_b': 1.0 + 0.1 * jax.random.normal(ks[14], (L, SGU_HEADS, SGU_CHUNK), jnp.float32),
        'attn_sinks': nrm(ks[15], (L, N_Q_HEADS), 0.5),
        'w_out': nrm(ks[16], (L, D_MIX, D), D_MIX ** -0.5),
        'norm_ffn2': gain(ks[17], (L, D)),
        'ffn2_w_in': nrm(ks[18], (L, D, 2 * F), D ** -0.5),
        'ffn2_w_out': nrm(ks[19], (L, F, D), F ** -0.5),
        'final_norm': gain(ks[20], (D,)),
    }


def reference(x, positions, norm_ffn1, ffn1_w_in, ffn1_w_out, norm_mix, w_in, conv_dw_w, conv_dw_b,
              conv_ln_g, conv_ln_b, sgu_ln_g, sgu_ln_b, sgu_w, sgu_b, attn_sinks, w_out,
              norm_ffn2, ffn2_w_in, ffn2_w_out, final_norm):
    B, S = x.shape[0], x.shape[1]
    cos, sin = rope_tables(positions)
    for l in range(DEPTH):
        h = rms_norm(x, norm_ffn1[l])
        x = x + FFN_RESIDUAL_WEIGHT * swiglu(h, ffn1_w_in[l], ffn1_w_out[l])
        h = rms_norm(x, norm_mix[l])
        p = h @ w_in[l]
        q = apply_partial_rope(p[..., :Q_END].reshape(B, S, N_Q_HEADS, HEAD_DIM), cos, sin)
        k = apply_partial_rope(p[..., Q_END:K_END].reshape(B, S, N_KV_HEADS, HEAD_DIM), cos, sin)
        v = p[..., K_END:V_END].reshape(B, S, N_KV_HEADS, HEAD_DIM)
        attn = sliding_window_attention(q, k, v, attn_sinks[l])
        conv = conv_module(p[..., V_END:CONV_END], conv_dw_w[l], conv_dw_b[l],
                           conv_ln_g[l], conv_ln_b[l])
        sgu = spatial_gating(p[..., CONV_END:], sgu_ln_g[l], sgu_ln_b[l],
                             sgu_w[l], sgu_b[l])
        x = x + jnp.concatenate([attn, conv, sgu], axis=-1) @ w_out[l]
        h = rms_norm(x, norm_ffn2[l])
        x = x + FFN_RESIDUAL_WEIGHT * swiglu(h, ffn2_w_in[l], ffn2_w_out[l])
    return rms_norm(x, final_norm)
```

```cpp
#include <hip/hip_runtime.h>
#include <hip/hip_cooperative_groups.h>
#include <cstdio>
#include <cstdint>
namespace cg = cooperative_groups;
namespace pg8 {
#define PG8_LAS __attribute__((address_space(3)))
typedef unsigned short bf16_t;
typedef short bf16x8 __attribute__((ext_vector_type(8)));
typedef float f32x4 __attribute__((ext_vector_type(4)));
typedef unsigned u32x4 __attribute__((ext_vector_type(4)));
constexpr int BM = 256, BK = 64, HALF = 128, HTB = HALF * BK * 2  , STAGE_BYTES = 8 * HTB, NXCD = 8, WGM = 8;

__host__ __device__ __forceinline__ int lds_byte(int r, int c) { const int st = (r >> 4) * 2 + (c >> 5), rr = r & 15, cc = c & 31, ob = rr * 64 + cc * 2; return st * 1024 + (ob ^ (((ob >> 9) & 1) << 5)); }
__host__ __device__ __forceinline__ void stage_rc(int b, int& R, int& C) { const int st = b / 1024, sb = b % 1024, swz = sb ^ (((sb >> 9) & 1) << 5); R = (st >> 1) * 16 + swz / 64; C = (st & 1) * 32 + (swz % 64) / 2; }
__host__ __device__ __forceinline__ int perm32(int rho) { const int n = rho >> 4, i = rho & 15; return 8 * (i >> 2) + 4 * n + (i & 3); }

struct Unit { int pm, pn; };
struct Gemm { const bf16_t* A; const bf16_t* Bt; int M, N, K; };

struct StaticOrder {
    int nM, nN, nwg, G, c;
    __host__ __device__ void init(int M, int N, int G_, int c_) { nM = M / BM; nN = N / BM; nwg = nM * nN; G = G_; c = c_; }
    __host__ __device__ bool next(int i, Unit& u) const {
        const long L = (long)i * G + c; if (L >= nwg) return false;
        int wgid = (int)L; { const int q = nwg / NXCD, r = nwg % NXCD, xcd = wgid % NXCD, off = wgid / NXCD; wgid = (xcd < r ? xcd * (q + 1) : r * (q + 1) + (xcd - r) * q) + off; }
        const int nig = WGM * nN, gid = wgid / nig, fm = gid * WGM, gsz = (nM - fm) < WGM ? (nM - fm) : WGM;
        u.pm = fm + ((wgid % nig) % gsz); u.pn = (wgid % nig) / gsz; return true;
    }
    __device__ __forceinline__ void a_ready(const Unit&) const {}
    __device__ __forceinline__ void done(const Unit&) const {}
};

__device__ __forceinline__ unsigned cvt_pk_bf16(float lo, float hi) { unsigned r; asm volatile("v_cvt_pk_bf16_f32 %0, %1, %2" : "=v"(r) : "v"(lo), "v"(hi)); return r; }
typedef float f32x2 __attribute__((ext_vector_type(2)));
template <class Epi, class Sched, bool ALIGN_EPI = false, bool SP2 = false>
__device__ __forceinline__ void gemm_phase(PG8_LAS unsigned char* lds, const Gemm g, const Sched& S, const Epi& E) {
    int tid_ = threadIdx.x; asm volatile("" : "+v"(tid_));
    const int tid = tid_, wid = __builtin_amdgcn_readfirstlane(tid >> 6), lane = tid & 63, wr = wid >> 2, wc = wid & 3, fr = lane & 15, fq = lane >> 4;
    const int K = g.K, nt = K / BK;
    unsigned voffA[2], voffB[2];
#pragma unroll
    for (int i = 0; i < 2; ++i) { int R, C; stage_rc(tid * 16 + i * 8192, R, C); const int Rb = Epi::PERM ? ((R & ~31) + perm32(R & 31)) : R;
        voffA[i] = (unsigned)(R * K + C) * 2u; voffB[i] = (unsigned)(Rb * K + C) * 2u; }
    const size_t kstep = (size_t)(BK * 2);
    const size_t hstep = (size_t)HALF * K * 2;
    const size_t tstep = 2 * hstep;
    const unsigned ldsw = (unsigned)wid * 1024u;
    const int aoff = lds_byte(wr * 64 + fr, fq * 8), boff = lds_byte(wc * 32 + fr, fq * 8);
#define PG8_SA(b, h) (((b) * 2 + (h)) * HTB)
#define PG8_SB(b, h) ((4 + (b) * 2 + (h)) * HTB)
#define PG8_STAGE(bufoff, gbase, voff) do { _Pragma("unroll") for (int _i = 0; _i < 2; ++_i) \
        __builtin_amdgcn_global_load_lds((const unsigned*)((const char*)(gbase) + (voff)[_i]), (PG8_LAS unsigned*)(lds + (bufoff) + ldsw + _i * 8192), 16, 0, 0); } while (0)
#define PG8_LDA(dst, b, h) do { _Pragma("unroll") for (int m = 0; m < 4; ++m) _Pragma("unroll") for (int k = 0; k < 2; ++k) dst[m][k] = *(const PG8_LAS bf16x8*)(lds + PG8_SA(b, h) + aoff + m * 2048 + k * 1024); } while (0)
#define PG8_LDB(dst, b, h) do { _Pragma("unroll") for (int n = 0; n < 2; ++n) _Pragma("unroll") for (int k = 0; k < 2; ++k) dst[n][k] = *(const PG8_LAS bf16x8*)(lds + PG8_SB(b, h) + boff + n * 2048 + k * 1024); } while (0)
#define PG8_MMA(ai, bj, At, Bt) do { __builtin_amdgcn_s_setprio(1); _Pragma("unroll") for (int m = 0; m < 4; ++m) _Pragma("unroll") for (int n = 0; n < 2; ++n) _Pragma("unroll") for (int k = 0; k < 2; ++k) \
        acc[ai][bj][m][n] = __builtin_amdgcn_mfma_f32_16x16x32_bf16(Bt[n][k], At[m][k], acc[ai][bj][m][n], 0, 0, 0); __builtin_amdgcn_s_setprio(0); } while (0)
#define PG8_WAIT_V(n) asm volatile("s_waitcnt vmcnt(" #n ")" ::: "memory")
#define PG8_WAIT_L(n) asm volatile("s_waitcnt lgkmcnt(" #n ")" ::: "memory")
#define PG8_BAR __builtin_amdgcn_s_barrier()
#define PG8_SCHED __builtin_amdgcn_sched_barrier(0)
    Unit cur, nxt; int ui = 0;
    if (!S.next(0, cur)) return;
    f32x4 acc[2][2][4][2];
#pragma unroll
    for (int a = 0; a < 2; ++a)
#pragma unroll
        for (int b = 0; b < 2; ++b)
#pragma unroll
            for (int m = 0; m < 4; ++m)
#pragma unroll
                for (int n = 0; n < 2; ++n) acc[a][b][m][n] = (f32x4){0.f, 0.f, 0.f, 0.f};
    bf16x8 At[4][2], B0[2][2], B1[2][2];
    const char* cA = (const char*)g.A + (size_t)cur.pm * tstep; const char* cB = (const char*)g.Bt + (size_t)cur.pn * tstep;
    S.a_ready(cur);
    if constexpr (SP2) {
        PG8_STAGE(PG8_SB(0, 0), cB, voffB); PG8_STAGE(PG8_SB(0, 1), cB + hstep, voffB); PG8_STAGE(PG8_SA(0, 0), cA, voffA); PG8_STAGE(PG8_SA(0, 1), cA + hstep, voffA);
        if (wr == 1) PG8_BAR;
        PG8_WAIT_V(2); PG8_BAR;
        PG8_STAGE(PG8_SB(1, 0), cB + kstep, voffB); PG8_STAGE(PG8_SA(1, 0), cA + kstep, voffA); PG8_STAGE(PG8_SB(1, 1), cB + hstep + kstep, voffB);
        PG8_WAIT_V(6); PG8_BAR;
    } else {
        PG8_STAGE(PG8_SB(0, 0), cB, voffB); PG8_STAGE(PG8_SA(0, 0), cA, voffA); PG8_STAGE(PG8_SB(0, 1), cB + hstep, voffB); PG8_STAGE(PG8_SA(0, 1), cA + hstep, voffA);
        if (wr == 1) PG8_BAR;
        PG8_WAIT_V(4); PG8_BAR;
        PG8_STAGE(PG8_SB(1, 0), cB + kstep, voffB); PG8_STAGE(PG8_SA(1, 0), cA + kstep, voffA); PG8_STAGE(PG8_SB(1, 1), cB + hstep + kstep, voffB);
        PG8_WAIT_V(6); PG8_BAR;
    }
    for (;;) {
        const bool has_next = S.next(ui + 1, nxt);
        const char* nA = has_next ? (const char*)g.A + (size_t)nxt.pm * tstep : cA; const char* nB = has_next ? (const char*)g.Bt + (size_t)nxt.pn * tstep : cB;
        for (int t = 0; t < nt; t += 2) {
            const bool last = (t == nt - 2);
            const char* a1 = cA + (size_t)(t + 1) * kstep;
            const char* a2 = last ? nA : cA + (size_t)(t + 2) * kstep; const char* b2 = last ? nB : cB + (size_t)(t + 2) * kstep;
            const char* a3 = a2 + kstep; const char* b3 = b2 + kstep;
            if (last && has_next) S.a_ready(nxt);
            if constexpr (SP2) {
            PG8_LDB(B0, 0, 0); PG8_LDB(B1, 0, 1); PG8_SCHED; PG8_LDA(At, 0, 0); PG8_STAGE(PG8_SA(1, 1), a1 + hstep, voffA);
            PG8_WAIT_V(8); PG8_WAIT_L(0); PG8_BAR; PG8_MMA(0, 0, At, B0); PG8_MMA(0, 1, At, B1); PG8_BAR; PG8_SCHED;
            PG8_LDA(At, 0, 1); PG8_STAGE(PG8_SB(0, 0), b2, voffB); PG8_STAGE(PG8_SB(0, 1), b2 + hstep, voffB); PG8_STAGE(PG8_SA(0, 0), a2, voffA);
            PG8_WAIT_V(8); PG8_WAIT_L(0); PG8_BAR; PG8_MMA(1, 0, At, B0); PG8_MMA(1, 1, At, B1); PG8_BAR; PG8_SCHED;
            PG8_LDB(B0, 1, 0); PG8_LDB(B1, 1, 1); PG8_SCHED; PG8_LDA(At, 1, 0); PG8_STAGE(PG8_SA(0, 1), a2 + hstep, voffA);
            PG8_WAIT_V(8); PG8_WAIT_L(0); PG8_BAR; PG8_MMA(0, 0, At, B0); PG8_MMA(0, 1, At, B1); PG8_BAR; PG8_SCHED;
            PG8_LDA(At, 1, 1); PG8_STAGE(PG8_SB(1, 0), b3, voffB); PG8_STAGE(PG8_SB(1, 1), b3 + hstep, voffB); PG8_STAGE(PG8_SA(1, 0), a3, voffA);
            PG8_WAIT_V(8); PG8_WAIT_L(0); PG8_BAR; PG8_MMA(1, 0, At, B0); PG8_MMA(1, 1, At, B1); PG8_BAR; PG8_SCHED;
            } else {
            PG8_LDB(B0, 0, 0); PG8_SCHED; PG8_LDA(At, 0, 0); PG8_STAGE(PG8_SA(1, 1), a1 + hstep, voffA);
            PG8_WAIT_L(8); PG8_BAR; PG8_WAIT_L(0); PG8_MMA(0, 0, At, B0); PG8_BAR; PG8_SCHED;
            PG8_LDB(B1, 0, 1); PG8_STAGE(PG8_SB(0, 0), b2, voffB);
            PG8_BAR; PG8_WAIT_L(0); PG8_MMA(0, 1, At, B1); PG8_BAR;
            PG8_LDA(At, 0, 1); PG8_STAGE(PG8_SA(0, 0), a2, voffA);
            PG8_BAR; PG8_WAIT_L(0); PG8_MMA(1, 0, At, B0); PG8_BAR; PG8_SCHED;
            PG8_STAGE(PG8_SB(0, 1), b2 + hstep, voffB);
            PG8_WAIT_V(6); PG8_BAR; PG8_MMA(1, 1, At, B1); PG8_BAR;
            PG8_LDB(B0, 1, 0); PG8_SCHED; PG8_LDA(At, 1, 0); PG8_STAGE(PG8_SA(0, 1), a2 + hstep, voffA);
            PG8_WAIT_L(8); PG8_BAR; PG8_WAIT_L(0); PG8_MMA(0, 0, At, B0); PG8_BAR; PG8_SCHED;
            PG8_LDB(B1, 1, 1); PG8_STAGE(PG8_SB(1, 0), b3, voffB);
            PG8_BAR; PG8_WAIT_L(0); PG8_MMA(0, 1, At, B1); PG8_BAR;
            PG8_LDA(At, 1, 1); PG8_STAGE(PG8_SA(1, 0), a3, voffA);
            PG8_BAR; PG8_WAIT_L(0); PG8_MMA(1, 0, At, B0); PG8_BAR; PG8_SCHED;
            PG8_STAGE(PG8_SB(1, 1), b3 + hstep, voffB);
            PG8_WAIT_V(6); PG8_BAR; PG8_MMA(1, 1, At, B1); PG8_BAR;
            }
        }
        if constexpr (ALIGN_EPI) { if (wr == 0) PG8_BAR; }
        if constexpr (!Epi::AFTER_DRAIN) { E(acc, cur, wr, wc, fr, fq); S.done(cur); }
        if (!has_next) break;
#pragma unroll
        for (int a = 0; a < 2; ++a)
#pragma unroll
            for (int b = 0; b < 2; ++b)
#pragma unroll
                for (int m = 0; m < 4; ++m)
#pragma unroll
                    for (int n = 0; n < 2; ++n) acc[a][b][m][n] = (f32x4){0.f, 0.f, 0.f, 0.f};
        cur = nxt; cA = nA; cB = nB; ++ui;
        if constexpr (ALIGN_EPI) { if (wr == 1) PG8_BAR; }
    }
    PG8_WAIT_V(0);
    if constexpr (!ALIGN_EPI) { if (wr == 0) PG8_BAR; }
    PG8_BAR;
    if constexpr (Epi::AFTER_DRAIN) { E.fused(acc, cur, wr, wc, fr, fq, lds, wid, lane); S.done(cur); }
#undef PG8_SA
#undef PG8_SB
#undef PG8_STAGE
#undef PG8_LDA
#undef PG8_LDB
#undef PG8_MMA
#undef PG8_WAIT_V
#undef PG8_WAIT_L
#undef PG8_BAR
#undef PG8_SCHED
}
}

#define LAS __attribute__((address_space(3)))
typedef unsigned short bf16;
typedef unsigned v4u __attribute__((ext_vector_type(4)));
typedef unsigned v2u __attribute__((ext_vector_type(2)));
typedef float f32x4 __attribute__((ext_vector_type(4)));
typedef short bf16x8 __attribute__((ext_vector_type(8)));
typedef LAS unsigned char* ldsp;

constexpr int M = 16384, D = 2048, FF = 5632, NFF = 2 * FF, NIN = 3584, PW = 3072, SEQ = 4096;
constexpr float EPS = 1e-5f, LOG2E = 1.4426950408889634f;
constexpr int NTHREADS = 512, NWAVES = 8;
constexpr int LDS_BYTES = 147456;

constexpr size_t MiB = 1u << 20;
constexpr size_t WS_SS = 1 * MiB;
constexpr size_t WS_CS = 2 * MiB;
constexpr size_t WS_W = 4 * MiB;
constexpr size_t WL_F1I = 0, WL_F1O = 44 * MiB, WL_IN = 66 * MiB, WL_OUT = 80 * MiB, WL_F2I = 88 * MiB, WL_F2O = 132 * MiB, WL_SIZE = 154 * MiB;
constexpr size_t WS_XB = WS_W + 2 * WL_SIZE;
constexpr size_t WS_ACT = WS_XB + 64 * MiB;
constexpr size_t WS_P = WS_ACT, WS_MX = WS_ACT + 96 * MiB;
constexpr size_t WS_END = WS_ACT + 176 * MiB;

__device__ __forceinline__ float bflo(unsigned u) { return __uint_as_float(u << 16); }
__device__ __forceinline__ float bfhi(unsigned u) { return __uint_as_float(u & 0xffff0000u); }
__device__ __forceinline__ unsigned pk(float lo, float hi) { return pg8::cvt_pk_bf16(lo, hi); }
__device__ __forceinline__ float wave_sum(float v) {
#pragma unroll
    for (int o = 1; o < 64; o <<= 1) v += __shfl_xor(v, o);
    return v;
}
__device__ __forceinline__ float fast_sigmoid(float x) { return __builtin_amdgcn_rcpf(1.0f + __builtin_amdgcn_exp2f(-x * LOG2E)); }

struct EpiSwiGLU {
    static constexpr bool PERM = true, AFTER_DRAIN = false;
    bf16* O; const float* ss;
    __device__ __forceinline__ void operator()(const f32x4 (&acc)[2][2][4][2], const pg8::Unit& u, int wr, int wc, int fr, int fq) const {
        const int row0 = u.pm * 256 + wr * 64 + fr, col0 = u.pn * 128 + wc * 32 + 8 * fq;
#pragma unroll
        for (int ai = 0; ai < 2; ++ai)
#pragma unroll
            for (int m = 0; m < 4; ++m) {
                const int row = row0 + ai * 128 + m * 16;
                const float r = rsqrtf(ss[row] * (1.0f / D) + EPS);
                float o[8];
#pragma unroll
                for (int n = 0; n < 2; ++n)
#pragma unroll
                    for (int i = 0; i < 4; ++i) { const float g = acc[ai][0][m][n][i] * r, uu = acc[ai][1][m][n][i] * r; o[4 * n + i] = g * fast_sigmoid(g) * uu; }
                v4u w; w.x = pk(o[0], o[1]); w.y = pk(o[2], o[3]); w.z = pk(o[4], o[5]); w.w = pk(o[6], o[7]);
                *(v4u*)(O + (size_t)row * FF + col0) = w;
                if (m & 1) asm volatile("" ::: "memory");
            }
    }
};
struct EpiResid {
    static constexpr bool PERM = true, AFTER_DRAIN = false;
    const float* base; float* out; bf16* xb; float* ss_out; float scale;
    __device__ __forceinline__ void operator()(const f32x4 (&acc)[2][2][4][2], const pg8::Unit& u, int wr, int wc, int fr, int fq) const {
        const int row0 = u.pm * 256 + wr * 64 + fr, col0 = u.pn * 256 + wc * 32 + 8 * fq;
#pragma unroll
        for (int ai = 0; ai < 2; ++ai)
#pragma unroll
            for (int m = 0; m < 4; ++m) {
                const int row = row0 + ai * 128 + m * 16; float sq = 0.f;
#pragma unroll
                for (int bj = 0; bj < 2; ++bj) {
                    const size_t off = (size_t)row * D + col0 + bj * 128;
                    const f32x4 b0 = *(const f32x4*)(base + off), b1 = *(const f32x4*)(base + off + 4);
                    const f32x4 x0 = b0 + acc[ai][bj][m][0] * scale, x1 = b1 + acc[ai][bj][m][1] * scale;
                    *(f32x4*)(out + off) = x0; *(f32x4*)(out + off + 4) = x1;
                    v4u w; w.x = pk(x0[0], x0[1]); w.y = pk(x0[2], x0[3]); w.z = pk(x1[0], x1[1]); w.w = pk(x1[2], x1[3]);
                    *(v4u*)(xb + off) = w;
                    sq += (x0[0] * x0[0] + x0[1] * x0[1]) + (x0[2] * x0[2] + x0[3] * x0[3]) + (x1[0] * x1[0] + x1[1] * x1[1]) + (x1[2] * x1[2] + x1[3] * x1[3]);
                }
                sq += __shfl_xor(sq, 16); sq += __shfl_xor(sq, 32);
                if (fq == 0) unsafeAtomicAdd(ss_out + row, sq);
                asm volatile("" ::: "memory");
            }
    }
};
struct EpiMixIn {
    static constexpr bool PERM = true, AFTER_DRAIN = false;
    bf16* P; const float* ss; const float* cs;
    __device__ __forceinline__ void operator()(const f32x4 (&acc)[2][2][4][2], const pg8::Unit& u, int wr, int wc, int fr, int fq) const {
        const int row0 = u.pm * 256 + wr * 64 + fr, pn = u.pn, lc = wc * 32 + 8 * fq;
#pragma unroll
        for (int ai = 0; ai < 2; ++ai)
#pragma unroll
            for (int m = 0; m < 4; ++m) {
                const int row = row0 + ai * 128 + m * 16;
                const float r = rsqrtf(ss[row] * (1.0f / D) + EPS);
                f32x4 a0 = acc[ai][0][m][0] * r, a1 = acc[ai][0][m][1] * r, b0 = acc[ai][1][m][0] * r, b1 = acc[ai][1][m][1] * r;
                bf16* prow = P + (size_t)row * PW;
                if (pn >= 6 && pn < 10) {
                    float o[8];
#pragma unroll
                    for (int i = 0; i < 4; ++i) { o[i] = a0[i] * fast_sigmoid(b0[i]); o[4 + i] = a1[i] * fast_sigmoid(b1[i]); }
                    v4u w; w.x = pk(o[0], o[1]); w.y = pk(o[2], o[3]); w.z = pk(o[4], o[5]); w.w = pk(o[6], o[7]);
                    *(v4u*)(prow + 1536 + 128 * (pn - 6) + lc) = w;
                } else {
                    if (pn < 5) {
                        if ((wc & 1) == 0) {
                            f32x4 pa0, pa1, pb0, pb1;
#pragma unroll
                            for (int i = 0; i < 4; ++i) { pa0[i] = __shfl_xor(a0[i], 16); pa1[i] = __shfl_xor(a1[i], 16); pb0[i] = __shfl_xor(b0[i], 16); pb1[i] = __shfl_xor(b1[i], 16); }
                            if (fq < 2) {
                                const float* c = cs + (size_t)row * 16;
                                const f32x4 c0 = *(const f32x4*)c, c1 = *(const f32x4*)(c + 4); f32x4 s0 = *(const f32x4*)(c + 8), s1 = *(const f32x4*)(c + 12);
                                if (fq == 0) { s0 = -s0; s1 = -s1; }
                                a0 = a0 * c0 + pa0 * s0; a1 = a1 * c1 + pa1 * s1; b0 = b0 * c0 + pb0 * s0; b1 = b1 * c1 + pb1 * s1;
                            }
                        }
                        if (pn < 4) { a0 = a0 * 0.125f; a1 = a1 * 0.125f; b0 = b0 * 0.125f; b1 = b1 * 0.125f; }
                    }
                    const int cb = (pn <= 5 ? 256 * pn : 256 * pn - 512) + lc;
                    v4u w; w.x = pk(a0[0], a0[1]); w.y = pk(a0[2], a0[3]); w.z = pk(a1[0], a1[1]); w.w = pk(a1[2], a1[3]);
                    *(v4u*)(prow + cb) = w;
                    v4u z; z.x = pk(b0[0], b0[1]); z.y = pk(b0[2], b0[3]); z.z = pk(b1[0], b1[1]); z.w = pk(b1[2], b1[3]);
                    *(v4u*)(prow + cb + 128) = z;
                }
                asm volatile("" ::: "memory");
            }
    }
};

__device__ __forceinline__ void transpose_item(const float* W, int K, int N, const float* g, bf16* WT, int k0, int n0, int sn0, LAS float* scr, int lane) {
#pragma unroll 8
    for (int i = 0; i < 32; ++i) { const int kk = 2 * i + (lane >> 5); float w = W[(size_t)(k0 + kk) * N + sn0 + (lane & 31)]; if (g) w *= g[k0 + kk]; scr[kk * 33 + (lane & 31)] = w; }
    asm volatile("s_waitcnt lgkmcnt(0)" ::: "memory");
    const int c = lane & 7;
#pragma unroll
    for (int j = 0; j < 4; ++j) { const int n = (lane >> 3) + 8 * j; const LAS float* s = scr + (8 * c) * 33 + n;
        v4u o; o.x = pk(s[0 * 33], s[1 * 33]); o.y = pk(s[2 * 33], s[3 * 33]); o.z = pk(s[4 * 33], s[5 * 33]); o.w = pk(s[6 * 33], s[7 * 33]);
        *(v4u*)(WT + (size_t)(n0 + n) * K + k0 + 8 * c) = o; }
    asm volatile("s_waitcnt lgkmcnt(0)" ::: "memory");
}
__device__ __forceinline__ int src_col(int mode, int n0) {
    if (mode == 1) return ((n0 >> 7) & 1) * FF + 128 * (n0 >> 8) + (n0 & 127);
    if (mode == 2) { const int pn = n0 >> 8; if (pn >= 6 && pn < 10) return 1536 + 512 * ((n0 >> 7) & 1) + 128 * (pn - 6) + (n0 & 127); }
    return n0;
}
__device__ __forceinline__ void convert_matrix(const float* W, int K, int N, const float* g, bf16* WT, int mode, int item, LAS float* scr, int lane) {
    const int nblk = N / 32, kb = item / nblk, nb = item % nblk;
    transpose_item(W, K, N, g, WT, 64 * kb, 32 * nb, src_col(mode, 32 * nb), scr, lane);
}

struct Args {
    const float* x; const int* pos;
    const float *norm_ffn1, *ffn1_w_in, *ffn1_w_out, *norm_mix, *w_in, *conv_dw_w, *conv_dw_b, *conv_ln_g, *conv_ln_b, *sgu_ln_g, *sgu_ln_b, *sgu_w, *sgu_b, *attn_sinks, *w_out,
        *norm_ffn2, *ffn2_w_in, *ffn2_w_out, *final_norm;
    float* out; unsigned char* ws;
};

__device__ __forceinline__ void prologue(const Args& a, ldsp lds, int gw, int NGW, int lane, int wave) {
    LAS float* scr = (LAS float*)(lds + wave * 16384);
    constexpr int I_FI = (D / 64) * (NFF / 32), I_FO = (FF / 64) * (D / 32), I_IN = (D / 64) * (NIN / 32), I_OUT = (D / 64) * (D / 32);
    constexpr int I_LAYER = 2 * I_FI + 2 * I_FO + I_IN + I_OUT;
    for (int it = gw; it < 2 * I_LAYER; it += NGW) {
        const int l = it / I_LAYER; int r = it % I_LAYER;
        unsigned char* wl = a.ws + WS_W + (size_t)l * WL_SIZE;
        if (r < I_FI) { convert_matrix(a.ffn1_w_in + (size_t)l * D * NFF, D, NFF, a.norm_ffn1 + l * D, (bf16*)(wl + WL_F1I), 1, r, scr, lane); continue; } r -= I_FI;
        if (r < I_FI) { convert_matrix(a.ffn2_w_in + (size_t)l * D * NFF, D, NFF, a.norm_ffn2 + l * D, (bf16*)(wl + WL_F2I), 1, r, scr, lane); continue; } r -= I_FI;
        if (r < I_IN) { convert_matrix(a.w_in + (size_t)l * D * NIN, D, NIN, a.norm_mix + l * D, (bf16*)(wl + WL_IN), 2, r, scr, lane); continue; } r -= I_IN;
        if (r < I_FO) { convert_matrix(a.ffn1_w_out + (size_t)l * FF * D, FF, D, nullptr, (bf16*)(wl + WL_F1O), 0, r, scr, lane); continue; } r -= I_FO;
        if (r < I_FO) { convert_matrix(a.ffn2_w_out + (size_t)l * FF * D, FF, D, nullptr, (bf16*)(wl + WL_F2O), 0, r, scr, lane); continue; } r -= I_FO;
        convert_matrix(a.w_out + (size_t)l * D * D, D, D, nullptr, (bf16*)(wl + WL_OUT), 0, r, scr, lane);
    }
}

__device__ __forceinline__ void prologue_rows(const Args& a, int gw, int NGW, int lane, int gtid, int NGT) {
    bf16* XB = (bf16*)(a.ws + WS_XB); float* ss0 = (float*)(a.ws + WS_SS);
    for (int m = gw; m < M; m += NGW) {
        const f32x4* xr = (const f32x4*)(a.x + (size_t)m * D) + lane; v2u* o8 = (v2u*)(XB + (size_t)m * D) + lane; float s = 0.f;
#pragma unroll
        for (int j = 0; j < 8; ++j) { const f32x4 v = xr[64 * j]; s += (v[0] * v[0] + v[1] * v[1]) + (v[2] * v[2] + v[3] * v[3]); v2u w; w.x = pk(v[0], v[1]); w.y = pk(v[2], v[3]); o8[64 * j] = w; }
        s = wave_sum(s);
        if (lane == 0) ss0[m] = s;
    }
    for (int i = gtid; i < 6 * M; i += NGT) ss0[M + i] = 0.f;
    float* cs = (float*)(a.ws + WS_CS);
    for (int i = gtid; i < M * 8; i += NGT) {
        const int m = i >> 3, f = i & 7;
        const float invf[8] = {1.0f, 0.193922758102417f, 0.03760603070259094f, 0.00729266507551074f, 0.001414213445968926f, 0.00027424818836152554f, 5.318296462064609e-05f, 1.0313385246263351e-05f};
        float fr_ = invf[0];
#pragma unroll
        for (int k = 1; k < 8; ++k) fr_ = (f == k) ? invf[k] : fr_;
        const float ang = (float)a.pos[m] * fr_;
        double t = (double)ang * 0.15915494309189533577; t -= __builtin_rint(t);
        const float tf = (float)t;
        cs[(size_t)m * 16 + f] = __builtin_amdgcn_cosf(tf); cs[(size_t)m * 16 + 8 + f] = __builtin_amdgcn_sinf(tf);
    }
}

#define MFMA16(a, b, c) __builtin_amdgcn_mfma_f32_16x16x32_bf16(a, b, c, 0, 0, 0)

__device__ __forceinline__ void attn_unit(ldsp lds, const bf16* P, bf16* MX, const float* sinks, int b, int n, int g, int tid) {
    const int lane = tid & 63, wid = tid >> 6, fr = lane & 15, fq = lane >> 4;
    ldsp Kl = lds; ldsp Vl = lds + 36864;
    const int tok0 = b * SEQ + n * 128;
#pragma unroll
    for (int i = 0; i < 4; ++i) {
        const int p = tid + 512 * i, key = p >> 3, ch = p & 7;
        v4u kv = {0u, 0u, 0u, 0u}, vv = {0u, 0u, 0u, 0u};
        if (n > 0 || key >= 128) { const bf16* src = P + (size_t)(tok0 - 128 + key) * PW + 64 * g + 8 * ch; kv = *(const v4u*)(src + 1024); vv = *(const v4u*)(src + 1280); }
        *(LAS v4u*)(Kl + key * 144 + ch * 16) = kv;
#pragma unroll
        for (int j = 0; j < 8; ++j) { const unsigned e = (vv[j >> 1] >> (16 * (j & 1))) & 0xffffu; *(LAS unsigned short*)(Vl + (8 * ch + j) * 528 + key * 2) = (unsigned short)e; }
    }
    __syncthreads();
    const int hq = 4 * g + (wid >> 1), half = wid & 1;
    const float sink = sinks[hq];
    for (int mt = 0; mt < 4; ++mt) {
        const int mp = 4 * half + mt;
        const bf16* qrow = P + (size_t)(tok0 + 16 * mp + fr) * PW + 64 * hq + 8 * fq;
        const bf16x8 q0 = *(const bf16x8*)qrow, q1 = *(const bf16x8*)(qrow + 32);
        f32x4 s[9];
#pragma unroll
        for (int kt = 0; kt < 9; ++kt) {
            ldsp kp = Kl + (16 * (mp + kt) + fr) * 144 + fq * 16;
            const bf16x8 k0 = *(const LAS bf16x8*)kp, k1 = *(const LAS bf16x8*)(kp + 64);
            f32x4 z = {0.f, 0.f, 0.f, 0.f};
            z = MFMA16(k0, q0, z); z = MFMA16(k1, q1, z); s[kt] = z;
        }
#pragma unroll
        for (int i = 0; i < 4; ++i) { if (!(4 * fq + i > fr)) s[0][i] = -1e30f; if (!(4 * fq + i <= fr)) s[8][i] = -1e30f; }
        if (n == 0) {
#pragma unroll
            for (int kt = 0; kt < 8; ++kt) if (mp + kt < 8) s[kt] = (f32x4){-1e30f, -1e30f, -1e30f, -1e30f};
        }
        float mx = sink;
#pragma unroll
        for (int kt = 0; kt < 9; ++kt) mx = fmaxf(mx, fmaxf(fmaxf(s[kt][0], s[kt][1]), fmaxf(s[kt][2], s[kt][3])));
        mx = fmaxf(mx, __shfl_xor(mx, 16)); mx = fmaxf(mx, __shfl_xor(mx, 32));
        float sum = 0.f;
#pragma unroll
        for (int kt = 0; kt < 9; ++kt)
#pragma unroll
            for (int i = 0; i < 4; ++i) { const float p = __builtin_amdgcn_exp2f((s[kt][i] - mx) * LOG2E); s[kt][i] = p; sum += p; }
        sum += __shfl_xor(sum, 16); sum += __shfl_xor(sum, 32);
        sum += __builtin_amdgcn_exp2f((sink - mx) * LOG2E);
        const float inv = 1.0f / sum;
        f32x4 o[4];
#pragma unroll
        for (int nd = 0; nd < 4; ++nd) o[nd] = (f32x4){0.f, 0.f, 0.f, 0.f};
#pragma unroll
        for (int sp = 0; sp < 5; ++sp) {
            const int tA = mp + 2 * sp, tB = (sp < 4) ? tA + 1 : tA;
            v4u pw; pw.x = pk(s[2 * sp][0], s[2 * sp][1]); pw.y = pk(s[2 * sp][2], s[2 * sp][3]);
            const int iB = (sp < 4) ? 2 * sp + 1 : 8;
            if (sp < 4) { pw.z = pk(s[iB][0], s[iB][1]); pw.w = pk(s[iB][2], s[iB][3]); } else { pw.z = 0u; pw.w = 0u; }
            const bf16x8 pf = __builtin_bit_cast(bf16x8, pw);
#pragma unroll
            for (int nd = 0; nd < 4; ++nd) {
                ldsp vr = Vl + (16 * nd + fr) * 528 + 8 * fq;
                v4u vw; const v2u va = *(const LAS v2u*)(vr + 32 * tA), vb = *(const LAS v2u*)(vr + 32 * tB);
                vw.x = va.x; vw.y = va.y; vw.z = vb.x; vw.w = vb.y;
                o[nd] = MFMA16(__builtin_bit_cast(bf16x8, vw), pf, o[nd]);
            }
        }
        bf16* orow = MX + (size_t)(tok0 + 16 * mp + fr) * D + 64 * hq + 4 * fq;
#pragma unroll
        for (int nd = 0; nd < 4; ++nd) { v2u w; w.x = pk(o[nd][0] * inv, o[nd][1] * inv); w.y = pk(o[nd][2] * inv, o[nd][3] * inv); *(v2u*)(orow + 16 * nd) = w; }
    }
    __syncthreads();
}

__device__ __forceinline__ void conv_unit(ldsp lds, const bf16* P, bf16* MX, const float* dw_w, const float* dw_b, const float* ln_g, const float* ln_b, int cu, int tid) {
    const int lane = tid & 63, wid = tid >> 6;
    const int tok0 = 64 * cu, s0 = tok0 & (SEQ - 1);
    for (int p = tid; p < 94 * 64; p += NTHREADS) {
        const int r = p >> 6, c = p & 63; v4u v = {0u, 0u, 0u, 0u};
        if (s0 - 30 + r >= 0) v = *(const v4u*)(P + (size_t)(tok0 - 30 + r) * PW + 1536 + 8 * c);
        *(LAS v4u*)(lds + r * 1040 + c * 16) = v;
    }
    __syncthreads();
    const int c0 = 8 * lane;
    float acc[8][8];
#pragma unroll
    for (int t = 0; t < 8; ++t)
#pragma unroll
        for (int c = 0; c < 8; ++c) acc[t][c] = 0.f;
#pragma unroll 1
    for (int j = 0; j < 31; ++j) {
        const f32x4 w0 = *(const f32x4*)(dw_w + j * 512 + c0), w1 = *(const f32x4*)(dw_w + j * 512 + c0 + 4);
#pragma unroll
        for (int t = 0; t < 8; ++t) {
            const v4u hv = *(const LAS v4u*)(lds + (8 * wid + t + j) * 1040 + lane * 16);
            acc[t][0] += bflo(hv.x) * w0[0]; acc[t][1] += bfhi(hv.x) * w0[1]; acc[t][2] += bflo(hv.y) * w0[2]; acc[t][3] += bfhi(hv.y) * w0[3];
            acc[t][4] += bflo(hv.z) * w1[0]; acc[t][5] += bfhi(hv.z) * w1[1]; acc[t][6] += bflo(hv.w) * w1[2]; acc[t][7] += bfhi(hv.w) * w1[3];
        }
    }
    const f32x4 bb0 = *(const f32x4*)(dw_b + c0), bb1 = *(const f32x4*)(dw_b + c0 + 4), g0 = *(const f32x4*)(ln_g + c0), g1 = *(const f32x4*)(ln_g + c0 + 4), e0 = *(const f32x4*)(ln_b + c0), e1 = *(const f32x4*)(ln_b + c0 + 4);
#pragma unroll
    for (int t = 0; t < 8; ++t) {
        float y[8]; float s = 0.f;
#pragma unroll
        for (int c = 0; c < 8; ++c) { y[c] = acc[t][c] + (c < 4 ? bb0[c & 3] : bb1[c & 3]); s += y[c]; }
        const float mean = wave_sum(s) * (1.0f / 512.0f); float q = 0.f;
#pragma unroll
        for (int c = 0; c < 8; ++c) { y[c] -= mean; q += y[c] * y[c]; }
        const float rstd = rsqrtf(wave_sum(q) * (1.0f / 512.0f) + EPS);
#pragma unroll
        for (int c = 0; c < 8; ++c) { const float yn = y[c] * rstd * (c < 4 ? g0[c & 3] : g1[c & 3]) + (c < 4 ? e0[c & 3] : e1[c & 3]); y[c] = yn * fast_sigmoid(yn); }
        v4u w; w.x = pk(y[0], y[1]); w.y = pk(y[2], y[3]); w.z = pk(y[4], y[5]); w.w = pk(y[6], y[7]);
        *(v4u*)(MX + (size_t)(tok0 + 8 * wid + t) * D + 1024 + c0) = w;
    }
    __syncthreads();
}

__device__ __forceinline__ void sgu_unit(ldsp lds, const bf16* P, bf16* MX, const float* ln_g, const float* ln_b, const float* w_s, const float* b_s, int ck, int hf, int tid) {
    const int lane = tid & 63, wid = tid >> 6, fr = lane & 15, fq = lane >> 4;
    const int tok0 = 128 * ck, c0 = 8 * lane;
    {
        const f32x4 g0 = *(const f32x4*)(ln_g + c0), g1 = *(const f32x4*)(ln_g + c0 + 4), e0 = *(const f32x4*)(ln_b + c0), e1 = *(const f32x4*)(ln_b + c0 + 4);
#pragma unroll 2
        for (int i = 0; i < 16; ++i) {
            const int sidx = 16 * wid + i;
            const v4u raw = *(const v4u*)(P + (size_t)(tok0 + sidx) * PW + 2560 + c0);
            float v[8] = {bflo(raw.x), bfhi(raw.x), bflo(raw.y), bfhi(raw.y), bflo(raw.z), bfhi(raw.z), bflo(raw.w), bfhi(raw.w)};
            float s = 0.f;
#pragma unroll
            for (int c = 0; c < 8; ++c) s += v[c];
            const float mean = wave_sum(s) * (1.0f / 512.0f); float q = 0.f;
#pragma unroll
            for (int c = 0; c < 8; ++c) { v[c] -= mean; q += v[c] * v[c]; }
            const float rstd = rsqrtf(wave_sum(q) * (1.0f / 512.0f) + EPS);
            if ((lane >> 5) == hf) {
#pragma unroll
                for (int c = 0; c < 8; ++c) { const float vn = v[c] * rstd * (c < 4 ? g0[c & 3] : g1[c & 3]) + (c < 4 ? e0[c & 3] : e1[c & 3]);
                    *(LAS unsigned short*)(lds + ((c0 & 255) + c) * 272 + 2 * sidx) = (unsigned short)(pk(vn, 0.f) & 0xffffu); }
            }
        }
    }
    __syncthreads();
    const int hl = wid >> 1, hh = 4 * hf + hl, th = wid & 1;
    for (int m = 0; m < 4; ++m) {
        const int t0 = 64 * th + 16 * m, t = t0 + fr;
        f32x4 acc[4];
#pragma unroll
        for (int nd = 0; nd < 4; ++nd) acc[nd] = (f32x4){0.f, 0.f, 0.f, 0.f};
        const float* wrow = w_s + ((size_t)hh * 128 + t) * 128;
        const int nks = (t0 + 15) / 32 + 1;
        for (int ks = 0; ks < nks; ++ks) {
            const int sb = 32 * ks + 8 * fq;
            f32x4 wa = *(const f32x4*)(wrow + sb), wb = *(const f32x4*)(wrow + sb + 4);
#pragma unroll
            for (int i = 0; i < 4; ++i) { wa[i] = (sb + i <= t) ? wa[i] : 0.f; wb[i] = (sb + 4 + i <= t) ? wb[i] : 0.f; }
            v4u ww; ww.x = pk(wa[0], wa[1]); ww.y = pk(wa[2], wa[3]); ww.z = pk(wb[0], wb[1]); ww.w = pk(wb[2], wb[3]);
            const bf16x8 wf = __builtin_bit_cast(bf16x8, ww);
#pragma unroll
            for (int nd = 0; nd < 4; ++nd) {
                const bf16x8 vf = *(const LAS bf16x8*)(lds + (64 * hl + 16 * nd + fr) * 272 + 64 * ks + 16 * fq);
                acc[nd] = MFMA16(vf, wf, acc[nd]);
            }
        }
        const float bias = b_s[hh * 128 + t];
#pragma unroll
        for (int nd = 0; nd < 4; ++nd) {
            const int ch = 64 * hh + 16 * nd + 4 * fq;
            const v2u uu = *(const v2u*)(P + (size_t)(tok0 + t) * PW + 2048 + ch);
            v2u w; w.x = pk((acc[nd][0] + bias) * bflo(uu.x), (acc[nd][1] + bias) * bfhi(uu.x)); w.y = pk((acc[nd][2] + bias) * bflo(uu.y), (acc[nd][3] + bias) * bfhi(uu.y));
            *(v2u*)(MX + (size_t)(tok0 + t) * D + 1536 + ch) = w;
        }
    }
    __syncthreads();
}

typedef const __attribute__((address_space(4))) Args* kargp;
__device__ __forceinline__ kargp kargs() { kargp p = (kargp)__builtin_amdgcn_kernarg_segment_ptr(); asm volatile("" : "+s"(p)); return p; }
__global__ void __launch_bounds__(NTHREADS, 2) fwd_megakernel(Args a_unused) {
    extern __shared__ __attribute__((aligned(16))) unsigned char lds_raw[];
    cg::grid_group grid = cg::this_grid();
    ldsp lds = (ldsp)lds_raw;
    const int tid = threadIdx.x, lane = tid & 63, wave = __builtin_amdgcn_readfirstlane(tid >> 6);
    const int G = gridDim.x, bid = blockIdx.x;
    const int gw = bid * NWAVES + wave, NGW = G * NWAVES, gtid = bid * NTHREADS + tid, NGT = G * NTHREADS;
    unsigned char* ws = kargs()->ws;

    prologue(a_unused, lds, gw, NGW, lane, wave); prologue_rows(a_unused, gw, NGW, lane, gtid, NGT);
    grid.sync();

    for (int step = 0; step < 6; ++step) {
        const int l = step / 3, sub = step % 3;
        ws = kargs()->ws; const unsigned char* wl = ws + WS_W + (size_t)l * WL_SIZE;
        float* ssb = (float*)(ws + WS_SS); const float* cs = (const float*)(ws + WS_CS);
        bf16* XB = (bf16*)(ws + WS_XB); bf16* ACT = (bf16*)(ws + WS_ACT); bf16* PB = (bf16*)(ws + WS_P); bf16* MX = (bf16*)(ws + WS_MX);
        const float* ss_in = ssb + (size_t)step * M; float* ss_out = ssb + (size_t)(step + 1) * M;
        const bf16* A2; const bf16* B2; int K2; float scale;
        if (sub != 1) {
            pg8::Gemm g{XB, (const bf16*)(wl + (sub == 0 ? WL_F1I : WL_F2I)), M, NFF, D}; pg8::StaticOrder S; S.init(M, NFF, G, bid);
            EpiSwiGLU E{ACT, ss_in};
            pg8::gemm_phase<EpiSwiGLU, pg8::StaticOrder, true, true>(lds, g, S, E);
            grid.sync();
            A2 = ACT; B2 = (const bf16*)(wl + (sub == 0 ? WL_F1O : WL_F2O)); K2 = FF; scale = 0.5f;
        } else {
            {
                pg8::Gemm g{XB, (const bf16*)(wl + WL_IN), M, NIN, D}; pg8::StaticOrder S; S.init(M, NIN, G, bid);
                EpiMixIn E{PB, ss_in, cs};
                pg8::gemm_phase<EpiMixIn, pg8::StaticOrder, true, true>(lds, g, S, E);
            }
            grid.sync();
            for (int u = bid; u < 1024; u += G) {
                kargp a = kargs(); int tl = threadIdx.x; asm volatile("" : "+v"(tl));
                if (u < 512) attn_unit(lds, PB, MX, a->attn_sinks + l * 16, u >> 7, (u & 127) >> 2, u & 3, tl);
                else if (u < 768) conv_unit(lds, PB, MX, a->conv_dw_w + (size_t)l * 31 * 512, a->conv_dw_b + l * 512, a->conv_ln_g + l * 512, a->conv_ln_b + l * 512, u - 512, tl);
                else sgu_unit(lds, PB, MX, a->sgu_ln_g + l * 512, a->sgu_ln_b + l * 512, a->sgu_w + (size_t)l * 8 * 128 * 128, a->sgu_b + l * 8 * 128, (u - 768) >> 1, (u - 768) & 1, tl);
            }
            grid.sync();
            A2 = MX; B2 = (const bf16*)(wl + WL_OUT); K2 = D; scale = 1.0f;
        }
        {
            pg8::Gemm g{A2, B2, M, D, K2}; pg8::StaticOrder S; S.init(M, D, G, bid);
            kargp a = kargs(); float* outp = a->out;
            EpiResid E{step == 0 ? a->x : (const float*)outp, outp, XB, ss_out, scale};
            pg8::gemm_phase<EpiResid, pg8::StaticOrder, true, true>(lds, g, S, E);
        }
        grid.sync();
    }
    {
        kargp a = kargs(); const float* ss = (const float*)(a->ws + WS_SS) + (size_t)6 * M; float* outp = a->out; const float* fng = a->final_norm;
        for (int m = gw; m < M; m += NGW) {
            const float r = rsqrtf(ss[m] * (1.0f / D) + EPS);
            f32x4* xr = (f32x4*)(outp + (size_t)m * D) + lane; const f32x4* gr = (const f32x4*)fng + lane;
#pragma unroll
            for (int j = 0; j < 8; ++j) { const f32x4 v = xr[64 * j], gg = gr[64 * j]; xr[64 * j] = v * r * gg; }
        }
    }
}

extern "C" void kernel_launch(void* const* d_in, const int* in_sizes, int n_in, void* d_out, int out_size, void* d_ws, size_t ws_size, hipStream_t stream) {
    static int grid_blocks = 0;
    if (grid_blocks == 0) {
        if (n_in != 21 || out_size != M * D || ws_size < WS_END) { fprintf(stderr, "kernel_launch: unexpected shapes (n_in %d out %d ws %zu need %zu)\n", n_in, out_size, ws_size, (size_t)WS_END); grid_blocks = -1; return; }
        int dev = 0, cus = 0, per_cu = 0;
        (void)hipGetDevice(&dev);
        (void)hipDeviceGetAttribute(&cus, hipDeviceAttributeMultiprocessorCount, dev);
        if (hipFuncSetAttribute((const void*)fwd_megakernel, hipFuncAttributeMaxDynamicSharedMemorySize, LDS_BYTES) != hipSuccess) { fprintf(stderr, "kernel_launch: hipFuncSetAttribute failed\n"); grid_blocks = -1; return; }
        if (hipOccupancyMaxActiveBlocksPerMultiprocessor(&per_cu, (const void*)fwd_megakernel, NTHREADS, LDS_BYTES) != hipSuccess || per_cu < 1) { fprintf(stderr, "kernel_launch: occupancy query says %d\n", per_cu); per_cu = 1; (void)hipGetLastError(); }
        grid_blocks = cus * per_cu;
    }
    if (grid_blocks < 0) return;
    Args a{};
    a.x = (const float*)d_in[0]; a.pos = (const int*)d_in[1];
    a.norm_ffn1 = (const float*)d_in[2]; a.ffn1_w_in = (const float*)d_in[3]; a.ffn1_w_out = (const float*)d_in[4]; a.norm_mix = (const float*)d_in[5]; a.w_in = (const float*)d_in[6];
    a.conv_dw_w = (const float*)d_in[7]; a.conv_dw_b = (const float*)d_in[8]; a.conv_ln_g = (const float*)d_in[9]; a.conv_ln_b = (const float*)d_in[10];
    a.sgu_ln_g = (const float*)d_in[11]; a.sgu_ln_b = (const float*)d_in[12]; a.sgu_w = (const float*)d_in[13]; a.sgu_b = (const float*)d_in[14]; a.attn_sinks = (const float*)d_in[15];
    a.w_out = (const float*)d_in[16]; a.norm_ffn2 = (const float*)d_in[17]; a.ffn2_w_in = (const float*)d_in[18]; a.ffn2_w_out = (const float*)d_in[19]; a.final_norm = (const float*)d_in[20];
    a.out = (float*)d_out; a.ws = (unsigned char*)d_ws;
    void* args[] = {&a};
    hipError_t e = hipLaunchCooperativeKernel((const void*)fwd_megakernel, dim3(grid_blocks), dim3(NTHREADS), args, LDS_BYTES, stream);
    if (e != hipSuccess) fprintf(stderr, "kernel_launch: cooperative launch failed: %s (grid %d)\n", hipGetErrorString(e), grid_blocks);
}
```

```cpp
#include <hip/hip_runtime.h>
#include <hip/hip_cooperative_groups.h>
#include <cstdio>
#include <cstdint>
namespace cg = cooperative_groups;
namespace pg8 {
#define PG8_LAS __attribute__((address_space(3)))
typedef unsigned short bf16_t;
typedef short bf16x8 __attribute__((ext_vector_type(8)));
typedef float f32x4 __attribute__((ext_vector_type(4)));
typedef unsigned u32x4 __attribute__((ext_vector_type(4)));
constexpr int BM = 256, BK = 64, HALF = 128, HTB = HALF * BK * 2  , STAGE_BYTES = 8 * HTB, NXCD = 8, WGM = 8;

__host__ __device__ __forceinline__ int lds_byte(int r, int c) { const int st = (r >> 4) * 2 + (c >> 5), rr = r & 15, cc = c & 31, ob = rr * 64 + cc * 2; return st * 1024 + (ob ^ (((ob >> 9) & 1) << 5)); }
__host__ __device__ __forceinline__ void stage_rc(int b, int& R, int& C) { const int st = b / 1024, sb = b % 1024, swz = sb ^ (((sb >> 9) & 1) << 5); R = (st >> 1) * 16 + swz / 64; C = (st & 1) * 32 + (swz % 64) / 2; }
__host__ __device__ __forceinline__ int perm32(int rho) { const int n = rho >> 4, i = rho & 15; return 8 * (i >> 2) + 4 * n + (i & 3); }

struct Unit { int pm, pn; };
struct Gemm { const bf16_t* A; const bf16_t* Bt; int M, N, K; };

struct StaticOrder {
    int nM, nN, nwg, G, c;
    __host__ __device__ void init(int M, int N, int G_, int c_) { nM = M / BM; nN = N / BM; nwg = nM * nN; G = G_; c = c_; }
    __host__ __device__ bool next(int i, Unit& u) const {
        const long L = (long)i * G + c; if (L >= nwg) return false;
        int wgid = (int)L; { const int q = nwg / NXCD, r = nwg % NXCD, xcd = wgid % NXCD, off = wgid / NXCD; wgid = (xcd < r ? xcd * (q + 1) : r * (q + 1) + (xcd - r) * q) + off; }
        const int nig = WGM * nN, gid = wgid / nig, fm = gid * WGM, gsz = (nM - fm) < WGM ? (nM - fm) : WGM;
        u.pm = fm + ((wgid % nig) % gsz); u.pn = (wgid % nig) / gsz; return true;
    }
    __device__ __forceinline__ void a_ready(const Unit&) const {}
    __device__ __forceinline__ void done(const Unit&) const {}
};

__device__ __forceinline__ unsigned cvt_pk_bf16(float lo, float hi) { unsigned r; asm volatile("v_cvt_pk_bf16_f32 %0, %1, %2" : "=v"(r) : "v"(lo), "v"(hi)); return r; }
typedef float f32x2 __attribute__((ext_vector_type(2)));
template <class Epi, class Sched, bool ALIGN_EPI = false, bool SP2 = false>
__device__ __forceinline__ void gemm_phase(PG8_LAS unsigned char* lds, const Gemm g, const Sched& S, const Epi& E) {
    int tid_ = threadIdx.x; asm volatile("" : "+v"(tid_));
    const int tid = tid_, wid = __builtin_amdgcn_readfirstlane(tid >> 6), lane = tid & 63, wr = wid >> 2, wc = wid & 3, fr = lane & 15, fq = lane >> 4;
    const int K = g.K, nt = K / BK;
    unsigned voffA[2], voffB[2];
#pragma unroll
    for (int i = 0; i < 2; ++i) { int R, C; stage_rc(tid * 16 + i * 8192, R, C); const int Rb = Epi::PERM ? ((R & ~31) + perm32(R & 31)) : R;
        voffA[i] = (unsigned)(R * K + C) * 2u; voffB[i] = (unsigned)(Rb * K + C) * 2u; }
    const size_t kstep = (size_t)(BK * 2);
    const size_t hstep = (size_t)HALF * K * 2;
    const size_t tstep = 2 * hstep;
    const unsigned ldsw = (unsigned)wid * 1024u;
    const int aoff = lds_byte(wr * 64 + fr, fq * 8), boff = lds_byte(wc * 32 + fr, fq * 8);
#define PG8_SA(b, h) (((b) * 2 + (h)) * HTB)
#define PG8_SB(b, h) ((4 + (b) * 2 + (h)) * HTB)
#define PG8_STAGE(bufoff, gbase, voff) do { _Pragma("unroll") for (int _i = 0; _i < 2; ++_i) \
        __builtin_amdgcn_global_load_lds((const unsigned*)((const char*)(gbase) + (voff)[_i]), (PG8_LAS unsigned*)(lds + (bufoff) + ldsw + _i * 8192), 16, 0, 0); } while (0)
#define PG8_LDA(dst, b, h) do { _Pragma("unroll") for (int m = 0; m < 4; ++m) _Pragma("unroll") for (int k = 0; k < 2; ++k) dst[m][k] = *(const PG8_LAS bf16x8*)(lds + PG8_SA(b, h) + aoff + m * 2048 + k * 1024); } while (0)
#define PG8_LDB(dst, b, h) do { _Pragma("unroll") for (int n = 0; n < 2; ++n) _Pragma("unroll") for (int k = 0; k < 2; ++k) dst[n][k] = *(const PG8_LAS bf16x8*)(lds + PG8_SB(b, h) + boff + n * 2048 + k * 1024); } while (0)
#define PG8_MMA(ai, bj, At, Bt) do { __builtin_amdgcn_s_setprio(1); _Pragma("unroll") for (int m = 0; m < 4; ++m) _Pragma("unroll") for (int n = 0; n < 2; ++n) _Pragma("unroll") for (int k = 0; k < 2; ++k) \
        acc[ai][bj][m][n] = __builtin_amdgcn_mfma_f32_16x16x32_bf16(Bt[n][k], At[m][k], acc[ai][bj][m][n], 0, 0, 0); __builtin_amdgcn_s_setprio(0); } while (0)
#define PG8_WAIT_V(n) asm volatile("s_waitcnt vmcnt(" #n ")" ::: "memory")
#define PG8_WAIT_L(n) asm volatile("s_waitcnt lgkmcnt(" #n ")" ::: "memory")
#define PG8_BAR __builtin_amdgcn_s_barrier()
#define PG8_SCHED __builtin_amdgcn_sched_barrier(0)
    Unit cur, nxt; int ui = 0;
    if (!S.next(0, cur)) return;
    f32x4 acc[2][2][4][2];
#pragma unroll
    for (int a = 0; a < 2; ++a)
#pragma unroll
        for (int b = 0; b < 2; ++b)
#pragma unroll
            for (int m = 0; m < 4; ++m)
#pragma unroll
                for (int n = 0; n < 2; ++n) acc[a][b][m][n] = (f32x4){0.f, 0.f, 0.f, 0.f};
    bf16x8 At[4][2], B0[2][2], B1[2][2];
    const char* cA = (const char*)g.A + (size_t)cur.pm * tstep; const char* cB = (const char*)g.Bt + (size_t)cur.pn * tstep;
    S.a_ready(cur);
    if constexpr (SP2) {
        PG8_STAGE(PG8_SB(0, 0), cB, voffB); PG8_STAGE(PG8_SB(0, 1), cB + hstep, voffB); PG8_STAGE(PG8_SA(0, 0), cA, voffA); PG8_STAGE(PG8_SA(0, 1), cA + hstep, voffA);
        if (wr == 1) PG8_BAR;
        PG8_WAIT_V(2); PG8_BAR;
        PG8_STAGE(PG8_SB(1, 0), cB + kstep, voffB); PG8_STAGE(PG8_SA(1, 0), cA + kstep, voffA); PG8_STAGE(PG8_SB(1, 1), cB + hstep + kstep, voffB);
        PG8_WAIT_V(6); PG8_BAR;
    } else {
        PG8_STAGE(PG8_SB(0, 0), cB, voffB); PG8_STAGE(PG8_SA(0, 0), cA, voffA); PG8_STAGE(PG8_SB(0, 1), cB + hstep, voffB); PG8_STAGE(PG8_SA(0, 1), cA + hstep, voffA);
        if (wr == 1) PG8_BAR;
        PG8_WAIT_V(4); PG8_BAR;
        PG8_STAGE(PG8_SB(1, 0), cB + kstep, voffB); PG8_STAGE(PG8_SA(1, 0), cA + kstep, voffA); PG8_STAGE(PG8_SB(1, 1), cB + hstep + kstep, voffB);
        PG8_WAIT_V(6); PG8_BAR;
    }
    for (;;) {
        const bool has_next = S.next(ui + 1, nxt);
        const char* nA = has_next ? (const char*)g.A + (size_t)nxt.pm * tstep : cA; const char* nB = has_next ? (const char*)g.Bt + (size_t)nxt.pn * tstep : cB;
        for (int t = 0; t < nt; t += 2) {
            const bool last = (t == nt - 2);
            const char* a1 = cA + (size_t)(t + 1) * kstep;
            const char* a2 = last ? nA : cA + (size_t)(t + 2) * kstep; const char* b2 = last ? nB : cB + (size_t)(t + 2) * kstep;
            const char* a3 = a2 + kstep; const char* b3 = b2 + kstep;
            if (last && has_next) S.a_ready(nxt);
            if constexpr (SP2) {
            PG8_LDB(B0, 0, 0); PG8_LDB(B1, 0, 1); PG8_SCHED; PG8_LDA(At, 0, 0); PG8_STAGE(PG8_SA(1, 1), a1 + hstep, voffA);
            PG8_WAIT_V(8); PG8_WAIT_L(0); PG8_BAR; PG8_MMA(0, 0, At, B0); PG8_MMA(0, 1, At, B1); PG8_BAR; PG8_SCHED;
            PG8_LDA(At, 0, 1); PG8_STAGE(PG8_SB(0, 0), b2, voffB); PG8_STAGE(PG8_SB(0, 1), b2 + hstep, voffB); PG8_STAGE(PG8_SA(0, 0), a2, voffA);
            PG8_WAIT_V(8); PG8_WAIT_L(0); PG8_BAR; PG8_MMA(1, 0, At, B0); PG8_MMA(1, 1, At, B1); PG8_BAR; PG8_SCHED;
            PG8_LDB(B0, 1, 0); PG8_LDB(B1, 1, 1); PG8_SCHED; PG8_LDA(At, 1, 0); PG8_STAGE(PG8_SA(0, 1), a2 + hstep, voffA);
            PG8_WAIT_V(8); PG8_WAIT_L(0); PG8_BAR; PG8_MMA(0, 0, At, B0); PG8_MMA(0, 1, At, B1); PG8_BAR; PG8_SCHED;
            PG8_LDA(At, 1, 1); PG8_STAGE(PG8_SB(1, 0), b3, voffB); PG8_STAGE(PG8_SB(1, 1), b3 + hstep, voffB); PG8_STAGE(PG8_SA(1, 0), a3, voffA);
            PG8_WAIT_V(8); PG8_WAIT_L(0); PG8_BAR; PG8_MMA(1, 0, At, B0); PG8_MMA(1, 1, At, B1); PG8_BAR; PG8_SCHED;
            } else {
            PG8_LDB(B0, 0, 0); PG8_SCHED; PG8_LDA(At, 0, 0); PG8_STAGE(PG8_SA(1, 1), a1 + hstep, voffA);
            PG8_WAIT_L(8); PG8_BAR; PG8_WAIT_L(0); PG8_MMA(0, 0, At, B0); PG8_BAR; PG8_SCHED;
            PG8_LDB(B1, 0, 1); PG8_STAGE(PG8_SB(0, 0), b2, voffB);
            PG8_BAR; PG8_WAIT_L(0); PG8_MMA(0, 1, At, B1); PG8_BAR;
            PG8_LDA(At, 0, 1); PG8_STAGE(PG8_SA(0, 0), a2, voffA);
            PG8_BAR; PG8_WAIT_L(0); PG8_MMA(1, 0, At, B0); PG8_BAR; PG8_SCHED;
            PG8_STAGE(PG8_SB(0, 1), b2 + hstep, voffB);
            PG8_WAIT_V(6); PG8_BAR; PG8_MMA(1, 1, At, B1); PG8_BAR;
            PG8_LDB(B0, 1, 0); PG8_SCHED; PG8_LDA(At, 1, 0); PG8_STAGE(PG8_SA(0, 1), a2 + hstep, voffA);
            PG8_WAIT_L(8); PG8_BAR; PG8_WAIT_L(0); PG8_MMA(0, 0, At, B0); PG8_BAR; PG8_SCHED;
            PG8_LDB(B1, 1, 1); PG8_STAGE(PG8_SB(1, 0), b3, voffB);
            PG8_BAR; PG8_WAIT_L(0); PG8_MMA(0, 1, At, B1); PG8_BAR;
            PG8_LDA(At, 1, 1); PG8_STAGE(PG8_SA(1, 0), a3, voffA);
            PG8_BAR; PG8_WAIT_L(0); PG8_MMA(1, 0, At, B0); PG8_BAR; PG8_SCHED;
            PG8_STAGE(PG8_SB(1, 1), b3 + hstep, voffB);
            PG8_WAIT_V(6); PG8_BAR; PG8_MMA(1, 1, At, B1); PG8_BAR;
            }
        }
        if constexpr (ALIGN_EPI) { if (wr == 0) PG8_BAR; }
        if constexpr (!Epi::AFTER_DRAIN) { E(acc, cur, wr, wc, fr, fq); S.done(cur); }
        if (!has_next) break;
#pragma unroll
        for (int a = 0; a < 2; ++a)
#pragma unroll
            for (int b = 0; b < 2; ++b)
#pragma unroll
                for (int m = 0; m < 4; ++m)
#pragma unroll
                    for (int n = 0; n < 2; ++n) acc[a][b][m][n] = (f32x4){0.f, 0.f, 0.f, 0.f};
        cur = nxt; cA = nA; cB = nB; ++ui;
        if constexpr (ALIGN_EPI) { if (wr == 1) PG8_BAR; }
    }
    PG8_WAIT_V(0);
    if constexpr (!ALIGN_EPI) { if (wr == 0) PG8_BAR; }
    PG8_BAR;
    if constexpr (Epi::AFTER_DRAIN) { E.fused(acc, cur, wr, wc, fr, fq, lds, wid, lane); S.done(cur); }
#undef PG8_SA
#undef PG8_SB
#undef PG8_STAGE
#undef PG8_LDA
#undef PG8_LDB
#undef PG8_MMA
#undef PG8_WAIT_V
#undef PG8_WAIT_L
#undef PG8_BAR
#undef PG8_SCHED
}
}

#define LAS __attribute__((address_space(3)))
typedef unsigned short bf16;
typedef unsigned v4u __attribute__((ext_vector_type(4)));
typedef unsigned v2u __attribute__((ext_vector_type(2)));
typedef float f32x4 __attribute__((ext_vector_type(4)));
typedef short bf16x8 __attribute__((ext_vector_type(8)));
typedef LAS unsigned char* ldsp;

constexpr int M = 16384, D = 2048, FF = 5632, NFF = 2 * FF, NIN = 3584, PW = 3072, SEQ = 4096;
constexpr float EPS = 1e-5f, LOG2E = 1.4426950408889634f;
constexpr int NTHREADS = 512, NWAVES = 8;
constexpr int LDS_BYTES = 147456;

constexpr size_t MiB = 1u << 20;
constexpr size_t WS_SS = 1 * MiB;
constexpr size_t WS_CS = 2 * MiB;
constexpr size_t WS_W = 4 * MiB;
constexpr size_t WL_F1I = 0, WL_F1O = 44 * MiB, WL_IN = 66 * MiB, WL_OUT = 80 * MiB, WL_F2I = 88 * MiB, WL_F2O = 132 * MiB, WL_SIZE = 154 * MiB;
constexpr size_t WS_XB = WS_W + 2 * WL_SIZE;
constexpr size_t WS_ACT = WS_XB + 64 * MiB;
constexpr size_t WS_P = WS_ACT, WS_MX = WS_ACT + 96 * MiB;
constexpr size_t WS_END = WS_ACT + 176 * MiB;

__device__ __forceinline__ float bflo(unsigned u) { return __uint_as_float(u << 16); }
__device__ __forceinline__ float bfhi(unsigned u) { return __uint_as_float(u & 0xffff0000u); }
__device__ __forceinline__ unsigned pk(float lo, float hi) { return pg8::cvt_pk_bf16(lo, hi); }
__device__ __forceinline__ float wave_sum(float v) {
#pragma unroll
    for (int o = 1; o < 64; o <<= 1) v += __shfl_xor(v, o);
    return v;
}
__device__ __forceinline__ float fast_sigmoid(float x) { return __builtin_amdgcn_rcpf(1.0f + __builtin_amdgcn_exp2f(-x * LOG2E)); }

struct EpiSwiGLU {
    static constexpr bool PERM = true, AFTER_DRAIN = false;
    bf16* O; const float* ss;
    __device__ __forceinline__ void operator()(const f32x4 (&acc)[2][2][4][2], const pg8::Unit& u, int wr, int wc, int fr, int fq) const {
        const int row0 = u.pm * 256 + wr * 64 + fr, col0 = u.pn * 128 + wc * 32 + 8 * fq;
#pragma unroll
        for (int ai = 0; ai < 2; ++ai)
#pragma unroll
            for (int m = 0; m < 4; ++m) {
                const int row = row0 + ai * 128 + m * 16;
                const float r = rsqrtf(ss[row] * (1.0f / D) + EPS);
                float o[8];
#pragma unroll
                for (int n = 0; n < 2; ++n)
#pragma unroll
                    for (int i = 0; i < 4; ++i) { const float g = acc[ai][0][m][n][i] * r, uu = acc[ai][1][m][n][i] * r; o[4 * n + i] = g * fast_sigmoid(g) * uu; }
                v4u w; w.x = pk(o[0], o[1]); w.y = pk(o[2], o[3]); w.z = pk(o[4], o[5]); w.w = pk(o[6], o[7]);
                *(v4u*)(O + (size_t)row * FF + col0) = w;
                if (m & 1) asm volatile("" ::: "memory");
            }
    }
};
struct EpiResid {
    static constexpr bool PERM = true, AFTER_DRAIN = false;
    const float* base; float* out; bf16* xb; float* ss_out; float scale;
    __device__ __forceinline__ void operator()(const f32x4 (&acc)[2][2][4][2], const pg8::Unit& u, int wr, int wc, int fr, int fq) const {
        const int row0 = u.pm * 256 + wr * 64 + fr, col0 = u.pn * 256 + wc * 32 + 8 * fq;
#pragma unroll
        for (int ai = 0; ai < 2; ++ai)
#pragma unroll
            for (int m = 0; m < 4; ++m) {
                const int row = row0 + ai * 128 + m * 16; float sq = 0.f;
#pragma unroll
                for (int bj = 0; bj < 2; ++bj) {
                    const size_t off = (size_t)row * D + col0 + bj * 128;
                    const f32x4 b0 = *(const f32x4*)(base + off), b1 = *(const f32x4*)(base + off + 4);
                    const f32x4 x0 = b0 + acc[ai][bj][m][0] * scale, x1 = b1 + acc[ai][bj][m][1] * scale;
                    *(f32x4*)(out + off) = x0; *(f32x4*)(out + off + 4) = x1;
                    v4u w; w.x = pk(x0[0], x0[1]); w.y = pk(x0[2], x0[3]); w.z = pk(x1[0], x1[1]); w.w = pk(x1[2], x1[3]);
                    *(v4u*)(xb + off) = w;
                    sq += (x0[0] * x0[0] + x0[1] * x0[1]) + (x0[2] * x0[2] + x0[3] * x0[3]) + (x1[0] * x1[0] + x1[1] * x1[1]) + (x1[2] * x1[2] + x1[3] * x1[3]);
                }
                sq += __shfl_xor(sq, 16); sq += __shfl_xor(sq, 32);
                if (fq == 0) unsafeAtomicAdd(ss_out + row, sq);
                asm volatile("" ::: "memory");
            }
    }
};
struct EpiMixIn {
    static constexpr bool PERM = true, AFTER_DRAIN = false;
    bf16* P; const float* ss; const float* cs;
    __device__ __forceinline__ void operator()(const f32x4 (&acc)[2][2][4][2], const pg8::Unit& u, int wr, int wc, int fr, int fq) const {
        const int row0 = u.pm * 256 + wr * 64 + fr, pn = u.pn, lc = wc * 32 + 8 * fq;
#pragma unroll
        for (int ai = 0; ai < 2; ++ai)
#pragma unroll
            for (int m = 0; m < 4; ++m) {
                const int row = row0 + ai * 128 + m * 16;
                const float r = rsqrtf(ss[row] * (1.0f / D) + EPS);
                f32x4 a0 = acc[ai][0][m][0] * r, a1 = acc[ai][0][m][1] * r, b0 = acc[ai][1][m][0] * r, b1 = acc[ai][1][m][1] * r;
                bf16* prow = P + (size_t)row * PW;
                if (pn >= 6 && pn < 10) {
                    float o[8];
#pragma unroll
                    for (int i = 0; i < 4; ++i) { o[i] = a0[i] * fast_sigmoid(b0[i]); o[4 + i] = a1[i] * fast_sigmoid(b1[i]); }
                    v4u w; w.x = pk(o[0], o[1]); w.y = pk(o[2], o[3]); w.z = pk(o[4], o[5]); w.w = pk(o[6], o[7]);
                    *(v4u*)(prow + 1536 + 128 * (pn - 6) + lc) = w;
                } else {
                    if (pn < 5) {
                        if ((wc & 1) == 0) {
                            f32x4 pa0, pa1, pb0, pb1;
#pragma unroll
                            for (int i = 0; i < 4; ++i) { pa0[i] = __shfl_xor(a0[i], 16); pa1[i] = __shfl_xor(a1[i], 16); pb0[i] = __shfl_xor(b0[i], 16); pb1[i] = __shfl_xor(b1[i], 16); }
                            if (fq < 2) {
                                const float* c = cs + (size_t)row * 16;
                                const f32x4 c0 = *(const f32x4*)c, c1 = *(const f32x4*)(c + 4); f32x4 s0 = *(const f32x4*)(c + 8), s1 = *(const f32x4*)(c + 12);
                                if (fq == 0) { s0 = -s0; s1 = -s1; }
                                a0 = a0 * c0 + pa0 * s0; a1 = a1 * c1 + pa1 * s1; b0 = b0 * c0 + pb0 * s0; b1 = b1 * c1 + pb1 * s1;
                            }
                        }
                        if (pn < 4) { a0 = a0 * 0.125f; a1 = a1 * 0.125f; b0 = b0 * 0.125f; b1 = b1 * 0.125f; }
                    }
                    const int cb = (pn <= 5 ? 256 * pn : 256 * pn - 512) + lc;
                    v4u w; w.x = pk(a0[0], a0[1]); w.y = pk(a0[2], a0[3]); w.z = pk(a1[0], a1[1]); w.w = pk(a1[2], a1[3]);
                    *(v4u*)(prow + cb) = w;
                    v4u z; z.x = pk(b0[0], b0[1]); z.y = pk(b0[2], b0[3]); z.z = pk(b1[0], b1[1]); z.w = pk(b1[2], b1[3]);
                    *(v4u*)(prow + cb + 128) = z;
                }
                asm volatile("" ::: "memory");
            }
    }
};

__device__ __forceinline__ void transpose_item(const float* W, int K, int N, const float* g, bf16* WT, int k0, int n0, int sn0, LAS float* scr, int lane) {
#pragma unroll
    for (int i = 0; i < 32; ++i) { const int kk = 2 * i + (lane >> 5); float w = W[(size_t)(k0 + kk) * N + sn0 + (lane & 31)]; if (g) w *= g[k0 + kk]; scr[kk * 33 + (lane & 31)] = w; }
    asm volatile("s_waitcnt lgkmcnt(0)" ::: "memory");
    const int c = lane & 7;
#pragma unroll
    for (int j = 0; j < 4; ++j) { const int n = (lane >> 3) + 8 * j; const LAS float* s = scr + (8 * c) * 33 + n;
        v4u o; o.x = pk(s[0 * 33], s[1 * 33]); o.y = pk(s[2 * 33], s[3 * 33]); o.z = pk(s[4 * 33], s[5 * 33]); o.w = pk(s[6 * 33], s[7 * 33]);
        *(v4u*)(WT + (size_t)(n0 + n) * K + k0 + 8 * c) = o; }
    asm volatile("s_waitcnt lgkmcnt(0)" ::: "memory");
}
__device__ __forceinline__ int src_col(int mode, int n0) {
    if (mode == 1) return ((n0 >> 7) & 1) * FF + 128 * (n0 >> 8) + (n0 & 127);
    if (mode == 2) { const int pn = n0 >> 8; if (pn >= 6 && pn < 10) return 1536 + 512 * ((n0 >> 7) & 1) + 128 * (pn - 6) + (n0 & 127); }
    return n0;
}
__device__ __forceinline__ void convert_matrix(const float* W, int K, int N, const float* g, bf16* WT, int mode, int item, LAS float* scr, int lane) {
    const int nblk = N / 32, kb = item / nblk, nb = item % nblk;
    transpose_item(W, K, N, g, WT, 64 * kb, 32 * nb, src_col(mode, 32 * nb), scr, lane);
}

struct Args {
    const float* x; const int* pos;
    const float *norm_ffn1, *ffn1_w_in, *ffn1_w_out, *norm_mix, *w_in, *conv_dw_w, *conv_dw_b, *conv_ln_g, *conv_ln_b, *sgu_ln_g, *sgu_ln_b, *sgu_w, *sgu_b, *attn_sinks, *w_out,
        *norm_ffn2, *ffn2_w_in, *ffn2_w_out, *final_norm;
    float* out; unsigned char* ws;
};

__device__ __forceinline__ void prologue(const Args& a, ldsp lds, int gw, int NGW, int lane, int wave) {
    LAS float* scr = (LAS float*)(lds + wave * 16384);
    constexpr int I_FI = (D / 64) * (NFF / 32), I_FO = (FF / 64) * (D / 32), I_IN = (D / 64) * (NIN / 32), I_OUT = (D / 64) * (D / 32);
    constexpr int I_LAYER = 2 * I_FI + 2 * I_FO + I_IN + I_OUT;
    for (int it = gw; it < 2 * I_LAYER; it += NGW) {
        const int l = it / I_LAYER; int r = it % I_LAYER;
        unsigned char* wl = a.ws + WS_W + (size_t)l * WL_SIZE;
        if (r < I_FI) { convert_matrix(a.ffn1_w_in + (size_t)l * D * NFF, D, NFF, a.norm_ffn1 + l * D, (bf16*)(wl + WL_F1I), 1, r, scr, lane); continue; } r -= I_FI;
        if (r < I_FI) { convert_matrix(a.ffn2_w_in + (size_t)l * D * NFF, D, NFF, a.norm_ffn2 + l * D, (bf16*)(wl + WL_F2I), 1, r, scr, lane); continue; } r -= I_FI;
        if (r < I_IN) { convert_matrix(a.w_in + (size_t)l * D * NIN, D, NIN, a.norm_mix + l * D, (bf16*)(wl + WL_IN), 2, r, scr, lane); continue; } r -= I_IN;
        if (r < I_FO) { convert_matrix(a.ffn1_w_out + (size_t)l * FF * D, FF, D, nullptr, (bf16*)(wl + WL_F1O), 0, r, scr, lane); continue; } r -= I_FO;
        if (r < I_FO) { convert_matrix(a.ffn2_w_out + (size_t)l * FF * D, FF, D, nullptr, (bf16*)(wl + WL_F2O), 0, r, scr, lane); continue; } r -= I_FO;
        convert_matrix(a.w_out + (size_t)l * D * D, D, D, nullptr, (bf16*)(wl + WL_OUT), 0, r, scr, lane);
    }
}

__device__ __forceinline__ void prologue_rows(const Args& a, int gw, int NGW, int lane, int gtid, int NGT) {
    bf16* XB = (bf16*)(a.ws + WS_XB); float* ss0 = (float*)(a.ws + WS_SS);
    for (int m = gw; m < M; m += NGW) {
        const f32x4* xr = (const f32x4*)(a.x + (size_t)m * D) + lane; v2u* o8 = (v2u*)(XB + (size_t)m * D) + lane; float s = 0.f;
#pragma unroll
        for (int j = 0; j < 8; ++j) { const f32x4 v = xr[64 * j]; s += (v[0] * v[0] + v[1] * v[1]) + (v[2] * v[2] + v[3] * v[3]); v2u w; w.x = pk(v[0], v[1]); w.y = pk(v[2], v[3]); o8[64 * j] = w; }
        s = wave_sum(s);
        if (lane == 0) ss0[m] = s;
    }
    for (int i = gtid; i < 6 * M; i += NGT) ss0[M + i] = 0.f;
    float* cs = (float*)(a.ws + WS_CS);
    for (int i = gtid; i < M * 8; i += NGT) {
        const int m = i >> 3, f = i & 7;
        const float invf[8] = {1.0f, 0.193922758102417f, 0.03760603070259094f, 0.00729266507551074f, 0.001414213445968926f, 0.00027424818836152554f, 5.318296462064609e-05f, 1.0313385246263351e-05f};
        float fr_ = invf[0];
#pragma unroll
        for (int k = 1; k < 8; ++k) fr_ = (f == k) ? invf[k] : fr_;
        const float ang = (float)a.pos[m] * fr_;
        double t = (double)ang * 0.15915494309189533577; t -= __builtin_rint(t);
        const float tf = (float)t;
        cs[(size_t)m * 16 + f] = __builtin_amdgcn_cosf(tf); cs[(size_t)m * 16 + 8 + f] = __builtin_amdgcn_sinf(tf);
    }
}

#define MFMA16(a, b, c) __builtin_amdgcn_mfma_f32_16x16x32_bf16(a, b, c, 0, 0, 0)

__device__ __forceinline__ void attn_unit(ldsp lds, const bf16* P, bf16* MX, const float* sinks, int b, int n, int g, int tid) {
    const int lane = tid & 63, wid = tid >> 6, fr = lane & 15, fq = lane >> 4;
    ldsp Kl = lds; ldsp Vl = lds + 36864;
    const int tok0 = b * SEQ + n * 128;
#pragma unroll
    for (int i = 0; i < 4; ++i) {
        const int p = tid + 512 * i, key = p >> 3, ch = p & 7;
        v4u kv = {0u, 0u, 0u, 0u}, vv = {0u, 0u, 0u, 0u};
        if (n > 0 || key >= 128) { const bf16* src = P + (size_t)(tok0 - 128 + key) * PW + 64 * g + 8 * ch; kv = *(const v4u*)(src + 1024); vv = *(const v4u*)(src + 1280); }
        *(LAS v4u*)(Kl + key * 144 + ch * 16) = kv;
#pragma unroll
        for (int j = 0; j < 8; ++j) { const unsigned e = (vv[j >> 1] >> (16 * (j & 1))) & 0xffffu; *(LAS unsigned short*)(Vl + (8 * ch + j) * 528 + key * 2) = (unsigned short)e; }
    }
    __syncthreads();
    const int hq = 4 * g + (wid >> 1), half = wid & 1;
    const float sink = sinks[hq];
    for (int mt = 0; mt < 4; ++mt) {
        const int mp = 4 * half + mt;
        const bf16* qrow = P + (size_t)(tok0 + 16 * mp + fr) * PW + 64 * hq + 8 * fq;
        const bf16x8 q0 = *(const bf16x8*)qrow, q1 = *(const bf16x8*)(qrow + 32);
        f32x4 s[9];
#pragma unroll
        for (int kt = 0; kt < 9; ++kt) {
            ldsp kp = Kl + (16 * (mp + kt) + fr) * 144 + fq * 16;
            const bf16x8 k0 = *(const LAS bf16x8*)kp, k1 = *(const LAS bf16x8*)(kp + 64);
            f32x4 z = {0.f, 0.f, 0.f, 0.f};
            z = MFMA16(k0, q0, z); z = MFMA16(k1, q1, z); s[kt] = z;
        }
#pragma unroll
        for (int i = 0; i < 4; ++i) { if (!(4 * fq + i > fr)) s[0][i] = -1e30f; if (!(4 * fq + i <= fr)) s[8][i] = -1e30f; }
        if (n == 0) {
#pragma unroll
            for (int kt = 0; kt < 8; ++kt) if (mp + kt < 8) s[kt] = (f32x4){-1e30f, -1e30f, -1e30f, -1e30f};
        }
        float mx = sink;
#pragma unroll
        for (int kt = 0; kt < 9; ++kt) mx = fmaxf(mx, fmaxf(fmaxf(s[kt][0], s[kt][1]), fmaxf(s[kt][2], s[kt][3])));
        mx = fmaxf(mx, __shfl_xor(mx, 16)); mx = fmaxf(mx, __shfl_xor(mx, 32));
        float sum = 0.f;
#pragma unroll
        for (int kt = 0; kt < 9; ++kt)
#pragma unroll
            for (int i = 0; i < 4; ++i) { const float p = __builtin_amdgcn_exp2f((s[kt][i] - mx) * LOG2E); s[kt][i] = p; sum += p; }
        sum += __shfl_xor(sum, 16); sum += __shfl_xor(sum, 32);
        sum += __builtin_amdgcn_exp2f((sink - mx) * LOG2E);
        const float inv = 1.0f / sum;
        f32x4 o[4];
#pragma unroll
        for (int nd = 0; nd < 4; ++nd) o[nd] = (f32x4){0.f, 0.f, 0.f, 0.f};
#pragma unroll
        for (int sp = 0; sp < 5; ++sp) {
            const int tA = mp + 2 * sp, tB = (sp < 4) ? tA + 1 : tA;
            v4u pw; pw.x = pk(s[2 * sp][0], s[2 * sp][1]); pw.y = pk(s[2 * sp][2], s[2 * sp][3]);
            const int iB = (sp < 4) ? 2 * sp + 1 : 8;
            if (sp < 4) { pw.z = pk(s[iB][0], s[iB][1]); pw.w = pk(s[iB][2], s[iB][3]); } else { pw.z = 0u; pw.w = 0u; }
            const bf16x8 pf = __builtin_bit_cast(bf16x8, pw);
#pragma unroll
            for (int nd = 0; nd < 4; ++nd) {
                ldsp vr = Vl + (16 * nd + fr) * 528 + 8 * fq;
                v4u vw; const v2u va = *(const LAS v2u*)(vr + 32 * tA), vb = *(const LAS v2u*)(vr + 32 * tB);
                vw.x = va.x; vw.y = va.y; vw.z = vb.x; vw.w = vb.y;
                o[nd] = MFMA16(__builtin_bit_cast(bf16x8, vw), pf, o[nd]);
            }
        }
        bf16* orow = MX + (size_t)(tok0 + 16 * mp + fr) * D + 64 * hq + 4 * fq;
#pragma unroll
        for (int nd = 0; nd < 4; ++nd) { v2u w; w.x = pk(o[nd][0] * inv, o[nd][1] * inv); w.y = pk(o[nd][2] * inv, o[nd][3] * inv); *(v2u*)(orow + 16 * nd) = w; }
    }
    __syncthreads();
}

__device__ __forceinline__ void conv_unit(ldsp lds, const bf16* P, bf16* MX, const float* dw_w, const float* dw_b, const float* ln_g, const float* ln_b, int cu, int tid) {
    const int lane = tid & 63, wid = tid >> 6;
    const int tok0 = 64 * cu, s0 = tok0 & (SEQ - 1);
    for (int p = tid; p < 94 * 64; p += NTHREADS) {
        const int r = p >> 6, c = p & 63; v4u v = {0u, 0u, 0u, 0u};
        if (s0 - 30 + r >= 0) v = *(const v4u*)(P + (size_t)(tok0 - 30 + r) * PW + 1536 + 8 * c);
        *(LAS v4u*)(lds + r * 1040 + c * 16) = v;
    }
    __syncthreads();
    const int c0 = 8 * lane;
    float acc[8][8];
#pragma unroll
    for (int t = 0; t < 8; ++t)
#pragma unroll
        for (int c = 0; c < 8; ++c) acc[t][c] = 0.f;
#pragma unroll 1
    for (int j = 0; j < 31; ++j) {
        const f32x4 w0 = *(const f32x4*)(dw_w + j * 512 + c0), w1 = *(const f32x4*)(dw_w + j * 512 + c0 + 4);
#pragma unroll
        for (int t = 0; t < 8; ++t) {
            const v4u hv = *(const LAS v4u*)(lds + (8 * wid + t + j) * 1040 + lane * 16);
            acc[t][0] += bflo(hv.x) * w0[0]; acc[t][1] += bfhi(hv.x) * w0[1]; acc[t][2] += bflo(hv.y) * w0[2]; acc[t][3] += bfhi(hv.y) * w0[3];
            acc[t][4] += bflo(hv.z) * w1[0]; acc[t][5] += bfhi(hv.z) * w1[1]; acc[t][6] += bflo(hv.w) * w1[2]; acc[t][7] += bfhi(hv.w) * w1[3];
        }
    }
    const f32x4 bb0 = *(const f32x4*)(dw_b + c0), bb1 = *(const f32x4*)(dw_b + c0 + 4), g0 = *(const f32x4*)(ln_g + c0), g1 = *(const f32x4*)(ln_g + c0 + 4), e0 = *(const f32x4*)(ln_b + c0), e1 = *(const f32x4*)(ln_b + c0 + 4);
#pragma unroll
    for (int t = 0; t < 8; ++t) {
        float y[8]; float s = 0.f;
#pragma unroll
        for (int c = 0; c < 8; ++c) { y[c] = acc[t][c] + (c < 4 ? bb0[c & 3] : bb1[c & 3]); s += y[c]; }
        const float mean = wave_sum(s) * (1.0f / 512.0f); float q = 0.f;
#pragma unroll
        for (int c = 0; c < 8; ++c) { y[c] -= mean; q += y[c] * y[c]; }
        const float rstd = rsqrtf(wave_sum(q) * (1.0f / 512.0f) + EPS);
#pragma unroll
        for (int c = 0; c < 8; ++c) { const float yn = y[c] * rstd * (c < 4 ? g0[c & 3] : g1[c & 3]) + (c < 4 ? e0[c & 3] : e1[c & 3]); y[c] = yn * fast_sigmoid(yn); }
        v4u w; w.x = pk(y[0], y[1]); w.y = pk(y[2], y[3]); w.z = pk(y[4], y[5]); w.w = pk(y[6], y[7]);
        *(v4u*)(MX + (size_t)(tok0 + 8 * wid + t) * D + 1024 + c0) = w;
    }
    __syncthreads();
}

__device__ __forceinline__ void sgu_unit(ldsp lds, const bf16* P, bf16* MX, const float* ln_g, const float* ln_b, const float* w_s, const float* b_s, int ck, int hf, int tid) {
    const int lane = tid & 63, wid = tid >> 6, fr = lane & 15, fq = lane >> 4;
    const int tok0 = 128 * ck, c0 = 8 * lane;
    {
        const f32x4 g0 = *(const f32x4*)(ln_g + c0), g1 = *(const f32x4*)(ln_g + c0 + 4), e0 = *(const f32x4*)(ln_b + c0), e1 = *(const f32x4*)(ln_b + c0 + 4);
#pragma unroll 2
        for (int i = 0; i < 16; ++i) {
            const int sidx = 16 * wid + i;
            const v4u raw = *(const v4u*)(P + (size_t)(tok0 + sidx) * PW + 2560 + c0);
            float v[8] = {bflo(raw.x), bfhi(raw.x), bflo(raw.y), bfhi(raw.y), bflo(raw.z), bfhi(raw.z), bflo(raw.w), bfhi(raw.w)};
            float s = 0.f;
#pragma unroll
            for (int c = 0; c < 8; ++c) s += v[c];
            const float mean = wave_sum(s) * (1.0f / 512.0f); float q = 0.f;
#pragma unroll
            for (int c = 0; c < 8; ++c) { v[c] -= mean; q += v[c] * v[c]; }
            const float rstd = rsqrtf(wave_sum(q) * (1.0f / 512.0f) + EPS);
            if ((lane >> 5) == hf) {
#pragma unroll
                for (int c = 0; c < 8; ++c) { const float vn = v[c] * rstd * (c < 4 ? g0[c & 3] : g1[c & 3]) + (c < 4 ? e0[c & 3] : e1[c & 3]);
                    *(LAS unsigned short*)(lds + ((c0 & 255) + c) * 272 + 2 * sidx) = (unsigned short)(pk(vn, 0.f) & 0xffffu); }
            }
        }
    }
    __syncthreads();
    const int hl = wid >> 1, hh = 4 * hf + hl, th = wid & 1;
    for (int m = 0; m < 4; ++m) {
        const int t0 = 64 * th + 16 * m, t = t0 + fr;
        f32x4 acc[4];
#pragma unroll
        for (int nd = 0; nd < 4; ++nd) acc[nd] = (f32x4){0.f, 0.f, 0.f, 0.f};
        const float* wrow = w_s + ((size_t)hh * 128 + t) * 128;
        const int nks = (t0 + 15) / 32 + 1;
        for (int ks = 0; ks < nks; ++ks) {
            const int sb = 32 * ks + 8 * fq;
            f32x4 wa = *(const f32x4*)(wrow + sb), wb = *(const f32x4*)(wrow + sb + 4);
#pragma unroll
            for (int i = 0; i < 4; ++i) { wa[i] = (sb + i <= t) ? wa[i] : 0.f; wb[i] = (sb + 4 + i <= t) ? wb[i] : 0.f; }
            v4u ww; ww.x = pk(wa[0], wa[1]); ww.y = pk(wa[2], wa[3]); ww.z = pk(wb[0], wb[1]); ww.w = pk(wb[2], wb[3]);
            const bf16x8 wf = __builtin_bit_cast(bf16x8, ww);
#pragma unroll
            for (int nd = 0; nd < 4; ++nd) {
                const bf16x8 vf = *(const LAS bf16x8*)(lds + (64 * hl + 16 * nd + fr) * 272 + 64 * ks + 16 * fq);
                acc[nd] = MFMA16(vf, wf, acc[nd]);
            }
        }
        const float bias = b_s[hh * 128 + t];
#pragma unroll
        for (int nd = 0; nd < 4; ++nd) {
            const int ch = 64 * hh + 16 * nd + 4 * fq;
            const v2u uu = *(const v2u*)(P + (size_t)(tok0 + t) * PW + 2048 + ch);
            v2u w; w.x = pk((acc[nd][0] + bias) * bflo(uu.x), (acc[nd][1] + bias) * bfhi(uu.x)); w.y = pk((acc[nd][2] + bias) * bflo(uu.y), (acc[nd][3] + bias) * bfhi(uu.y));
            *(v2u*)(MX + (size_t)(tok0 + t) * D + 1536 + ch) = w;
        }
    }
    __syncthreads();
}

#define XB_TMO      128
#define XB_XCNT(j)  (256  + 64 * (j))
#define XB_XSUB(j)  (1280 + 64 * (j))
#define XB_XGEN(j)  (2304 + 64 * (j))
#define XB_TOP      3328
#define XB_TOPGEN   3392
#define XCD_BAR_WORDS 3456
#define XB_SPIN_CAP (1u << 23)

__device__ __forceinline__ unsigned xb_ld(unsigned* p)              { return __hip_atomic_load(p, __ATOMIC_RELAXED, __HIP_MEMORY_SCOPE_AGENT); }
__device__ __forceinline__ unsigned xb_add(unsigned* p, unsigned v) { return __hip_atomic_fetch_add(p, v, __ATOMIC_RELAXED, __HIP_MEMORY_SCOPE_AGENT); }
__device__ __forceinline__ unsigned xb_xcc_id() { return (unsigned)__builtin_amdgcn_s_getreg((3 << 11) | 20) & 0xFu; }
#define XB_SPIN(cond, bar) do { unsigned _sp = 0; while (cond) { __builtin_amdgcn_s_sleep(1); \
    if ((++_sp & 255u) == 0u) { if (xb_ld(&(bar)[XB_TMO])) break; if (_sp > XB_SPIN_CAP) { atomicAdd(&(bar)[XB_TMO], 1u); break; } } } } while (0)

struct XcdBarrier {
    unsigned* bar; unsigned x;
    volatile LAS unsigned* st;
};

__device__ __forceinline__ XcdBarrier xcd_barrier_post(unsigned* bar, volatile LAS unsigned* st) {
    XcdBarrier b; b.bar = bar; b.x = xb_xcc_id(); b.st = st;
    if (threadIdx.x == 0) (void)xb_add(&bar[XB_XCNT(b.x)], 1u);
    return b;
}
__device__ __forceinline__ void xcd_barrier_complete(unsigned* bar, unsigned x, unsigned& nloc, unsigned& nx) {
    const unsigned G = gridDim.x * gridDim.y * gridDim.z;
    unsigned sum, cnt, mine, sp = 0u;
    for (;;) {
        sum = 0u; cnt = 0u; mine = 0u;
#pragma unroll
        for (unsigned j = 0; j < 16; ++j) { const unsigned c = xb_ld(&bar[XB_XCNT(j)]); sum += c; cnt += (c > 0u) ? 1u : 0u; mine = (j == x) ? c : mine; }
        if (sum == G) break;
        __builtin_amdgcn_s_sleep(1);
        if ((++sp & 255u) == 0u) { if (xb_ld(&bar[XB_TMO])) break; if (sp > XB_SPIN_CAP) { atomicAdd(&bar[XB_TMO], 1u); break; } }
    }
    nloc = mine > 0u ? mine : 1u; nx = cnt > 0u ? cnt : 1u;
}

__device__ __forceinline__ void xcd_barrier(const XcdBarrier& b) {
    asm volatile("s_waitcnt vmcnt(0)" ::: "memory");
    __syncthreads();
    if (threadIdx.x == 0) {
        unsigned* bar = b.bar;
        __builtin_amdgcn_s_waitcnt(0);
        unsigned nloc = b.st[0], nx = b.st[1];
        if (nloc == 0u) { xcd_barrier_complete(bar, b.x, nloc, nx); b.st[0] = nloc; b.st[1] = nx; }
        const unsigned old = xb_add(&bar[XB_XSUB(b.x)], 1u);
        const unsigned gen = old / nloc;
        if (old + 1u == (gen + 1u) * nloc) {
            __builtin_amdgcn_fence(__ATOMIC_RELEASE, "agent");
            asm volatile("s_waitcnt vmcnt(0)" ::: "memory");
            const unsigned og = xb_add(&bar[XB_TOP], 1u);
            const unsigned tg = og / nx;
            if (og + 1u == (tg + 1u) * nx) xb_add(&bar[XB_TOPGEN], 1u);
            else XB_SPIN(xb_ld(&bar[XB_TOPGEN]) == tg, bar);
            __builtin_amdgcn_fence(__ATOMIC_ACQUIRE, "agent");
            xb_add(&bar[XB_XGEN(b.x)], 1u);
            asm volatile("s_waitcnt vmcnt(0)" ::: "memory");
        } else {
            XB_SPIN(xb_ld(&bar[XB_XGEN(b.x)]) == gen, bar);
            __builtin_amdgcn_fence(__ATOMIC_ACQUIRE, "agent");
            asm volatile("s_waitcnt vmcnt(0)" ::: "memory");
        }
    }
    __syncthreads();
}

typedef const __attribute__((address_space(4))) Args* kargp;
__device__ __forceinline__ kargp kargs() { kargp p = (kargp)__builtin_amdgcn_kernarg_segment_ptr(); asm volatile("" : "+s"(p)); return p; }
__global__ void __launch_bounds__(NTHREADS, 2) fwd_megakernel(Args a_unused) {
    extern __shared__ __attribute__((aligned(16))) unsigned char lds_raw[];
    cg::grid_group grid = cg::this_grid();
    ldsp lds = (ldsp)lds_raw;
    const int tid = threadIdx.x, lane = tid & 63, wave = __builtin_amdgcn_readfirstlane(tid >> 6);
    const int G = gridDim.x, bid = blockIdx.x;
    const int gw = bid * NWAVES + wave, NGW = G * NWAVES, gtid = bid * NTHREADS + tid, NGT = G * NTHREADS;
    unsigned char* ws = kargs()->ws;

#ifndef PROBE_PRO
#define PROBE_PRO 1
#endif
#ifndef PROBE_MIX
#define PROBE_MIX 1
#endif
#ifndef PROBE_FFI
#define PROBE_FFI 1
#endif
    volatile LAS unsigned* bar_st = (volatile LAS unsigned*)(lds + LDS_BYTES - 64);
    if (tid < 2) bar_st[tid] = 0u;
    if (bid == 0) { unsigned* bw = (unsigned*)a_unused.ws; for (int i = tid; i < XCD_BAR_WORDS; i += NTHREADS) bw[i] = 0u; }
    for (int rep = 0; rep < PROBE_PRO; ++rep) prologue(a_unused, lds, gw, NGW, lane, wave);
    prologue_rows(a_unused, gw, NGW, lane, gtid, NGT);
    grid.sync();
    const XcdBarrier xbar = xcd_barrier_post((unsigned*)ws, bar_st);

    for (int step = 0; step < 6; ++step) {
        const int l = step / 3, sub = step % 3;
        ws = kargs()->ws; const unsigned char* wl = ws + WS_W + (size_t)l * WL_SIZE;
        float* ssb = (float*)(ws + WS_SS); const float* cs = (const float*)(ws + WS_CS);
        bf16* XB = (bf16*)(ws + WS_XB); bf16* ACT = (bf16*)(ws + WS_ACT); bf16* PB = (bf16*)(ws + WS_P); bf16* MX = (bf16*)(ws + WS_MX);
        const float* ss_in = ssb + (size_t)step * M; float* ss_out = ssb + (size_t)(step + 1) * M;
        const bf16* A2; const bf16* B2; int K2; float scale;
        if (sub != 1) {
            pg8::Gemm g{XB, (const bf16*)(wl + (sub == 0 ? WL_F1I : WL_F2I)), M, NFF, D}; pg8::StaticOrder S; S.init(M, NFF, G, bid);
            EpiSwiGLU E{ACT, ss_in};
            for (int rep = 0; rep < PROBE_FFI; ++rep) pg8::gemm_phase<EpiSwiGLU, pg8::StaticOrder, true, true>(lds, g, S, E);
            xcd_barrier(xbar);
            A2 = ACT; B2 = (const bf16*)(wl + (sub == 0 ? WL_F1O : WL_F2O)); K2 = FF; scale = 0.5f;
        } else {
            {
                pg8::Gemm g{XB, (const bf16*)(wl + WL_IN), M, NIN, D}; pg8::StaticOrder S; S.init(M, NIN, G, bid);
                EpiMixIn E{PB, ss_in, cs};
                pg8::gemm_phase<EpiMixIn, pg8::StaticOrder, true, true>(lds, g, S, E);
            }
            xcd_barrier(xbar);
            for (int rep = 0; rep < PROBE_MIX; ++rep)
            for (int u = bid; u < 1024; u += G) {
                kargp a = kargs(); int tl = threadIdx.x; asm volatile("" : "+v"(tl));
                if (u < 512) attn_unit(lds, PB, MX, a->attn_sinks + l * 16, u >> 7, (u & 127) >> 2, u & 3, tl);
                else if (u < 768) conv_unit(lds, PB, MX, a->conv_dw_w + (size_t)l * 31 * 512, a->conv_dw_b + l * 512, a->conv_ln_g + l * 512, a->conv_ln_b + l * 512, u - 512, tl);
                else sgu_unit(lds, PB, MX, a->sgu_ln_g + l * 512, a->sgu_ln_b + l * 512, a->sgu_w + (size_t)l * 8 * 128 * 128, a->sgu_b + l * 8 * 128, (u - 768) >> 1, (u - 768) & 1, tl);
            }
            xcd_barrier(xbar);
            A2 = MX; B2 = (const bf16*)(wl + WL_OUT); K2 = D; scale = 1.0f;
        }
        {
            pg8::Gemm g{A2, B2, M, D, K2}; pg8::StaticOrder S; S.init(M, D, G, bid);
            kargp a = kargs(); float* outp = a->out;
            EpiResid E{step == 0 ? a->x : (const float*)outp, outp, XB, ss_out, scale};
            pg8::gemm_phase<EpiResid, pg8::StaticOrder, true, true>(lds, g, S, E);
        }
        xcd_barrier(xbar);
    }
    {
        kargp a = kargs(); const float* ss = (const float*)(a->ws + WS_SS) + (size_t)6 * M; float* outp = a->out; const float* fng = a->final_norm;
        for (int m = gw; m < M; m += NGW) {
            const float r = rsqrtf(ss[m] * (1.0f / D) + EPS);
            f32x4* xr = (f32x4*)(outp + (size_t)m * D) + lane; const f32x4* gr = (const f32x4*)fng + lane;
#pragma unroll
            for (int j = 0; j < 8; ++j) { const f32x4 v = xr[64 * j], gg = gr[64 * j]; xr[64 * j] = v * r * gg; }
        }
    }
}

extern "C" void kernel_launch(void* const* d_in, const int* in_sizes, int n_in, void* d_out, int out_size, void* d_ws, size_t ws_size, hipStream_t stream) {
    static int grid_blocks = 0;
    if (grid_blocks == 0) {
        if (n_in != 21 || out_size != M * D || ws_size < WS_END) { fprintf(stderr, "kernel_launch: unexpected shapes (n_in %d out %d ws %zu need %zu)\n", n_in, out_size, ws_size, (size_t)WS_END); grid_blocks = -1; return; }
        int dev = 0, cus = 0, per_cu = 0;
        (void)hipGetDevice(&dev);
        (void)hipDeviceGetAttribute(&cus, hipDeviceAttributeMultiprocessorCount, dev);
        if (hipFuncSetAttribute((const void*)fwd_megakernel, hipFuncAttributeMaxDynamicSharedMemorySize, LDS_BYTES) != hipSuccess) { fprintf(stderr, "kernel_launch: hipFuncSetAttribute failed\n"); grid_blocks = -1; return; }
        if (hipOccupancyMaxActiveBlocksPerMultiprocessor(&per_cu, (const void*)fwd_megakernel, NTHREADS, LDS_BYTES) != hipSuccess || per_cu < 1) { fprintf(stderr, "kernel_launch: occupancy query says %d\n", per_cu); per_cu = 1; (void)hipGetLastError(); }
        grid_blocks = cus * per_cu;
    }
    if (grid_blocks < 0) return;
    Args a{};
    a.x = (const float*)d_in[0]; a.pos = (const int*)d_in[1];
    a.norm_ffn1 = (const float*)d_in[2]; a.ffn1_w_in = (const float*)d_in[3]; a.ffn1_w_out = (const float*)d_in[4]; a.norm_mix = (const float*)d_in[5]; a.w_in = (const float*)d_in[6];
    a.conv_dw_w = (const float*)d_in[7]; a.conv_dw_b = (const float*)d_in[8]; a.conv_ln_g = (const float*)d_in[9]; a.conv_ln_b = (const float*)d_in[10];
    a.sgu_ln_g = (const float*)d_in[11]; a.sgu_ln_b = (const float*)d_in[12]; a.sgu_w = (const float*)d_in[13]; a.sgu_b = (const float*)d_in[14]; a.attn_sinks = (const float*)d_in[15];
    a.w_out = (const float*)d_in[16]; a.norm_ffn2 = (const float*)d_in[17]; a.ffn2_w_in = (const float*)d_in[18]; a.ffn2_w_out = (const float*)d_in[19]; a.final_norm = (const float*)d_in[20];
    a.out = (float*)d_out; a.ws = (unsigned char*)d_ws;
    void* args[] = {&a};
    hipError_t e = hipLaunchCooperativeKernel((const void*)fwd_megakernel, dim3(grid_blocks), dim3(NTHREADS), args, LDS_BYTES, stream);
    if (e != hipSuccess) fprintf(stderr, "kernel_launch: cooperative launch failed: %s (grid %d)\n", hipGetErrorString(e), grid_blocks);
}
```

```cpp
#include <hip/hip_runtime.h>
#include <hip/hip_cooperative_groups.h>
#include <cstdio>
#include <cstdint>
namespace cg = cooperative_groups;
namespace pg8 {
#define PG8_LAS __attribute__((address_space(3)))
typedef unsigned short bf16_t;
typedef short bf16x8 __attribute__((ext_vector_type(8)));
typedef float f32x4 __attribute__((ext_vector_type(4)));
typedef unsigned u32x4 __attribute__((ext_vector_type(4)));
constexpr int BM = 256, BK = 64, HALF = 128, HTB = HALF * BK * 2  , STAGE_BYTES = 8 * HTB, NXCD = 8, WGM = 8;

__host__ __device__ __forceinline__ int lds_byte(int r, int c) { const int st = (r >> 4) * 2 + (c >> 5), rr = r & 15, cc = c & 31, ob = rr * 64 + cc * 2; return st * 1024 + (ob ^ (((ob >> 9) & 1) << 5)); }
__host__ __device__ __forceinline__ void stage_rc(int b, int& R, int& C) { const int st = b / 1024, sb = b % 1024, swz = sb ^ (((sb >> 9) & 1) << 5); R = (st >> 1) * 16 + swz / 64; C = (st & 1) * 32 + (swz % 64) / 2; }
__host__ __device__ __forceinline__ int perm32(int rho) { const int n = rho >> 4, i = rho & 15; return 8 * (i >> 2) + 4 * n + (i & 3); }

struct Unit { int pm, pn; };
struct Gemm { const bf16_t* A; const bf16_t* Bt; int M, N, K; };

struct StaticOrder {
    int nM, nN, nwg, G, c;
    __host__ __device__ void init(int M, int N, int G_, int c_) { nM = M / BM; nN = N / BM; nwg = nM * nN; G = G_; c = c_; }
    __host__ __device__ bool next(int i, Unit& u) const {
        const long L = (long)i * G + c; if (L >= nwg) return false;
        int wgid = (int)L; { const int q = nwg / NXCD, r = nwg % NXCD, xcd = wgid % NXCD, off = wgid / NXCD; wgid = (xcd < r ? xcd * (q + 1) : r * (q + 1) + (xcd - r) * q) + off; }
        const int nig = WGM * nN, gid = wgid / nig, fm = gid * WGM, gsz = (nM - fm) < WGM ? (nM - fm) : WGM;
        u.pm = fm + ((wgid % nig) % gsz); u.pn = (wgid % nig) / gsz; return true;
    }
    __device__ __forceinline__ void a_ready(const Unit&) const {}
    __device__ __forceinline__ void done(const Unit&) const {}
};

__device__ __forceinline__ unsigned cvt_pk_bf16(float lo, float hi) { unsigned r; asm volatile("v_cvt_pk_bf16_f32 %0, %1, %2" : "=v"(r) : "v"(lo), "v"(hi)); return r; }
typedef float f32x2 __attribute__((ext_vector_type(2)));
template <class Epi, class Sched, bool ALIGN_EPI = false, bool SP2 = false>
__device__ __forceinline__ void gemm_phase(PG8_LAS unsigned char* lds, const Gemm g, const Sched& S, const Epi& E) {
    int tid_ = threadIdx.x; asm volatile("" : "+v"(tid_));
    const int tid = tid_, wid = __builtin_amdgcn_readfirstlane(tid >> 6), lane = tid & 63, wr = wid >> 2, wc = wid & 3, fr = lane & 15, fq = lane >> 4;
    const int K = g.K, nt = K / BK;
    unsigned voffA[2], voffB[2];
#pragma unroll
    for (int i = 0; i < 2; ++i) { int R, C; stage_rc(tid * 16 + i * 8192, R, C); const int Rb = Epi::PERM ? ((R & ~31) + perm32(R & 31)) : R;
        voffA[i] = (unsigned)(R * K + C) * 2u; voffB[i] = (unsigned)(Rb * K + C) * 2u; }
    const size_t kstep = (size_t)(BK * 2);
    const size_t hstep = (size_t)HALF * K * 2;
    const size_t tstep = 2 * hstep;
    const unsigned ldsw = (unsigned)wid * 1024u;
    const int aoff = lds_byte(wr * 64 + fr, fq * 8), boff = lds_byte(wc * 32 + fr, fq * 8);
#define PG8_SA(b, h) (((b) * 2 + (h)) * HTB)
#define PG8_SB(b, h) ((4 + (b) * 2 + (h)) * HTB)
#define PG8_STAGE(bufoff, gbase, voff) do { _Pragma("unroll") for (int _i = 0; _i < 2; ++_i) \
        __builtin_amdgcn_global_load_lds((const unsigned*)((const char*)(gbase) + (voff)[_i]), (PG8_LAS unsigned*)(lds + (bufoff) + ldsw + _i * 8192), 16, 0, 0); } while (0)
#define PG8_LDA(dst, b, h) do { _Pragma("unroll") for (int m = 0; m < 4; ++m) _Pragma("unroll") for (int k = 0; k < 2; ++k) dst[m][k] = *(const PG8_LAS bf16x8*)(lds + PG8_SA(b, h) + aoff + m * 2048 + k * 1024); } while (0)
#define PG8_LDB(dst, b, h) do { _Pragma("unroll") for (int n = 0; n < 2; ++n) _Pragma("unroll") for (int k = 0; k < 2; ++k) dst[n][k] = *(const PG8_LAS bf16x8*)(lds + PG8_SB(b, h) + boff + n * 2048 + k * 1024); } while (0)
#define PG8_MMA(ai, bj, At, Bt) do { __builtin_amdgcn_s_setprio(1); _Pragma("unroll") for (int m = 0; m < 4; ++m) _Pragma("unroll") for (int n = 0; n < 2; ++n) _Pragma("unroll") for (int k = 0; k < 2; ++k) \
        acc[ai][bj][m][n] = __builtin_amdgcn_mfma_f32_16x16x32_bf16(Bt[n][k], At[m][k], acc[ai][bj][m][n], 0, 0, 0); __builtin_amdgcn_s_setprio(0); } while (0)
#define PG8_WAIT_V(n) asm volatile("s_waitcnt vmcnt(" #n ")" ::: "memory")
#define PG8_WAIT_L(n) asm volatile("s_waitcnt lgkmcnt(" #n ")" ::: "memory")
#define PG8_BAR __builtin_amdgcn_s_barrier()
#define PG8_SCHED __builtin_amdgcn_sched_barrier(0)
    Unit cur, nxt; int ui = 0;
    if (!S.next(0, cur)) return;
    f32x4 acc[2][2][4][2];
#pragma unroll
    for (int a = 0; a < 2; ++a)
#pragma unroll
        for (int b = 0; b < 2; ++b)
#pragma unroll
            for (int m = 0; m < 4; ++m)
#pragma unroll
                for (int n = 0; n < 2; ++n) acc[a][b][m][n] = (f32x4){0.f, 0.f, 0.f, 0.f};
    bf16x8 At[4][2], B0[2][2], B1[2][2];
    const char* cA = (const char*)g.A + (size_t)cur.pm * tstep; const char* cB = (const char*)g.Bt + (size_t)cur.pn * tstep;
    S.a_ready(cur);
    if constexpr (SP2) {
        PG8_STAGE(PG8_SB(0, 0), cB, voffB); PG8_STAGE(PG8_SB(0, 1), cB + hstep, voffB); PG8_STAGE(PG8_SA(0, 0), cA, voffA); PG8_STAGE(PG8_SA(0, 1), cA + hstep, voffA);
        if (wr == 1) PG8_BAR;
        PG8_WAIT_V(2); PG8_BAR;
        PG8_STAGE(PG8_SB(1, 0), cB + kstep, voffB); PG8_STAGE(PG8_SA(1, 0), cA + kstep, voffA); PG8_STAGE(PG8_SB(1, 1), cB + hstep + kstep, voffB);
        PG8_WAIT_V(6); PG8_BAR;
    } else {
        PG8_STAGE(PG8_SB(0, 0), cB, voffB); PG8_STAGE(PG8_SA(0, 0), cA, voffA); PG8_STAGE(PG8_SB(0, 1), cB + hstep, voffB); PG8_STAGE(PG8_SA(0, 1), cA + hstep, voffA);
        if (wr == 1) PG8_BAR;
        PG8_WAIT_V(4); PG8_BAR;
        PG8_STAGE(PG8_SB(1, 0), cB + kstep, voffB); PG8_STAGE(PG8_SA(1, 0), cA + kstep, voffA); PG8_STAGE(PG8_SB(1, 1), cB + hstep + kstep, voffB);
        PG8_WAIT_V(6); PG8_BAR;
    }
    for (;;) {
        const bool has_next = S.next(ui + 1, nxt);
        const char* nA = has_next ? (const char*)g.A + (size_t)nxt.pm * tstep : cA; const char* nB = has_next ? (const char*)g.Bt + (size_t)nxt.pn * tstep : cB;
        for (int t = 0; t < nt; t += 2) {
            const bool last = (t == nt - 2);
            const char* a1 = cA + (size_t)(t + 1) * kstep;
            const char* a2 = last ? nA : cA + (size_t)(t + 2) * kstep; const char* b2 = last ? nB : cB + (size_t)(t + 2) * kstep;
            const char* a3 = a2 + kstep; const char* b3 = b2 + kstep;
            if (last && has_next) S.a_ready(nxt);
            if constexpr (SP2) {
            PG8_LDB(B0, 0, 0); PG8_LDB(B1, 0, 1); PG8_SCHED; PG8_LDA(At, 0, 0); PG8_STAGE(PG8_SA(1, 1), a1 + hstep, voffA);
            PG8_WAIT_V(8); PG8_WAIT_L(0); PG8_BAR; PG8_MMA(0, 0, At, B0); PG8_MMA(0, 1, At, B1); PG8_BAR; PG8_SCHED;
            PG8_LDA(At, 0, 1); PG8_STAGE(PG8_SB(0, 0), b2, voffB); PG8_STAGE(PG8_SB(0, 1), b2 + hstep, voffB); PG8_STAGE(PG8_SA(0, 0), a2, voffA);
            PG8_WAIT_V(8); PG8_WAIT_L(0); PG8_BAR; PG8_MMA(1, 0, At, B0); PG8_MMA(1, 1, At, B1); PG8_BAR; PG8_SCHED;
            PG8_LDB(B0, 1, 0); PG8_LDB(B1, 1, 1); PG8_SCHED; PG8_LDA(At, 1, 0); PG8_STAGE(PG8_SA(0, 1), a2 + hstep, voffA);
            PG8_WAIT_V(8); PG8_WAIT_L(0); PG8_BAR; PG8_MMA(0, 0, At, B0); PG8_MMA(0, 1, At, B1); PG8_BAR; PG8_SCHED;
            PG8_LDA(At, 1, 1); PG8_STAGE(PG8_SB(1, 0), b3, voffB); PG8_STAGE(PG8_SB(1, 1), b3 + hstep, voffB); PG8_STAGE(PG8_SA(1, 0), a3, voffA);
            PG8_WAIT_V(8); PG8_WAIT_L(0); PG8_BAR; PG8_MMA(1, 0, At, B0); PG8_MMA(1, 1, At, B1); PG8_BAR; PG8_SCHED;
            } else {
            PG8_LDB(B0, 0, 0); PG8_SCHED; PG8_LDA(At, 0, 0); PG8_STAGE(PG8_SA(1, 1), a1 + hstep, voffA);
            PG8_WAIT_L(8); PG8_BAR; PG8_WAIT_L(0); PG8_MMA(0, 0, At, B0); PG8_BAR; PG8_SCHED;
            PG8_LDB(B1, 0, 1); PG8_STAGE(PG8_SB(0, 0), b2, voffB);
            PG8_BAR; PG8_WAIT_L(0); PG8_MMA(0, 1, At, B1); PG8_BAR;
            PG8_LDA(At, 0, 1); PG8_STAGE(PG8_SA(0, 0), a2, voffA);
            PG8_BAR; PG8_WAIT_L(0); PG8_MMA(1, 0, At, B0); PG8_BAR; PG8_SCHED;
            PG8_STAGE(PG8_SB(0, 1), b2 + hstep, voffB);
            PG8_WAIT_V(6); PG8_BAR; PG8_MMA(1, 1, At, B1); PG8_BAR;
            PG8_LDB(B0, 1, 0); PG8_SCHED; PG8_LDA(At, 1, 0); PG8_STAGE(PG8_SA(0, 1), a2 + hstep, voffA);
            PG8_WAIT_L(8); PG8_BAR; PG8_WAIT_L(0); PG8_MMA(0, 0, At, B0); PG8_BAR; PG8_SCHED;
            PG8_LDB(B1, 1, 1); PG8_STAGE(PG8_SB(1, 0), b3, voffB);
            PG8_BAR; PG8_WAIT_L(0); PG8_MMA(0, 1, At, B1); PG8_BAR;
            PG8_LDA(At, 1, 1); PG8_STAGE(PG8_SA(1, 0), a3, voffA);
            PG8_BAR; PG8_WAIT_L(0); PG8_MMA(1, 0, At, B0); PG8_BAR; PG8_SCHED;
            PG8_STAGE(PG8_SB(1, 1), b3 + hstep, voffB);
            PG8_WAIT_V(6); PG8_BAR; PG8_MMA(1, 1, At, B1); PG8_BAR;
            }
        }
        if constexpr (ALIGN_EPI) { if (wr == 0) PG8_BAR; }
        if constexpr (!Epi::AFTER_DRAIN) { E(acc, cur, wr, wc, fr, fq); S.done(cur); }
        if (!has_next) break;
#pragma unroll
        for (int a = 0; a < 2; ++a)
#pragma unroll
            for (int b = 0; b < 2; ++b)
#pragma unroll
                for (int m = 0; m < 4; ++m)
#pragma unroll
                    for (int n = 0; n < 2; ++n) acc[a][b][m][n] = (f32x4){0.f, 0.f, 0.f, 0.f};
        cur = nxt; cA = nA; cB = nB; ++ui;
        if constexpr (ALIGN_EPI) { if (wr == 1) PG8_BAR; }
    }
    PG8_WAIT_V(0);
    if constexpr (!ALIGN_EPI) { if (wr == 0) PG8_BAR; }
    PG8_BAR;
    if constexpr (Epi::AFTER_DRAIN) { E.fused(acc, cur, wr, wc, fr, fq, lds, wid, lane); S.done(cur); }
#undef PG8_SA
#undef PG8_SB
#undef PG8_STAGE
#undef PG8_LDA
#undef PG8_LDB
#undef PG8_MMA
#undef PG8_WAIT_V
#undef PG8_WAIT_L
#undef PG8_BAR
#undef PG8_SCHED
}
}

#define LAS __attribute__((address_space(3)))
typedef unsigned short bf16;
typedef unsigned v4u __attribute__((ext_vector_type(4)));
typedef unsigned v2u __attribute__((ext_vector_type(2)));
typedef float f32x4 __attribute__((ext_vector_type(4)));
typedef short bf16x8 __attribute__((ext_vector_type(8)));
typedef LAS unsigned char* ldsp;

constexpr int M = 16384, D = 2048, FF = 5632, NFF = 2 * FF, NIN = 3584, PW = 3072, SEQ = 4096;
constexpr float EPS = 1e-5f, LOG2E = 1.4426950408889634f;
constexpr int NTHREADS = 512, NWAVES = 8;
constexpr int LDS_BYTES = 147456;

constexpr size_t MiB = 1u << 20;
constexpr size_t WS_SS = 1 * MiB;
constexpr size_t WS_CS = 2 * MiB;
constexpr size_t WS_W = 4 * MiB;
constexpr size_t WL_F1I = 0, WL_F1O = 44 * MiB, WL_IN = 66 * MiB, WL_OUT = 80 * MiB, WL_F2I = 88 * MiB, WL_F2O = 132 * MiB, WL_SIZE = 154 * MiB;
constexpr size_t WS_XB = WS_W + 2 * WL_SIZE;
constexpr size_t WS_ACT = WS_XB + 64 * MiB;
constexpr size_t WS_P = WS_ACT, WS_MX = WS_ACT + 96 * MiB;
constexpr size_t WS_END = WS_ACT + 176 * MiB;

__device__ __forceinline__ float bflo(unsigned u) { return __uint_as_float(u << 16); }
__device__ __forceinline__ float bfhi(unsigned u) { return __uint_as_float(u & 0xffff0000u); }
__device__ __forceinline__ unsigned pk(float lo, float hi) { return pg8::cvt_pk_bf16(lo, hi); }
__device__ __forceinline__ float wave_sum(float v) {
    v += __builtin_bit_cast(float, __builtin_amdgcn_update_dpp(0, __builtin_bit_cast(int, v), 0x111, 0xf, 0xf, true));
    v += __builtin_bit_cast(float, __builtin_amdgcn_update_dpp(0, __builtin_bit_cast(int, v), 0x112, 0xf, 0xf, true));
    v += __builtin_bit_cast(float, __builtin_amdgcn_update_dpp(0, __builtin_bit_cast(int, v), 0x114, 0xf, 0xf, true));
    v += __builtin_bit_cast(float, __builtin_amdgcn_update_dpp(0, __builtin_bit_cast(int, v), 0x118, 0xf, 0xf, true));
    v += __builtin_bit_cast(float, __builtin_amdgcn_update_dpp(0, __builtin_bit_cast(int, v), 0x142, 0xa, 0xf, false));
    v += __builtin_bit_cast(float, __builtin_amdgcn_update_dpp(0, __builtin_bit_cast(int, v), 0x143, 0xc, 0xf, false));
    return __builtin_bit_cast(float, __builtin_amdgcn_readlane(__builtin_bit_cast(int, v), 63));
}
__device__ __forceinline__ float fast_sigmoid(float x) { return __builtin_amdgcn_rcpf(1.0f + __builtin_amdgcn_exp2f(-x * LOG2E)); }

struct EpiSwiGLU {
    static constexpr bool PERM = true, AFTER_DRAIN = false;
    bf16* O; const float* ss;
    __device__ __forceinline__ void operator()(const f32x4 (&acc)[2][2][4][2], const pg8::Unit& u, int wr, int wc, int fr, int fq) const {
        const int row0 = u.pm * 256 + wr * 64 + fr, col0 = u.pn * 128 + wc * 32 + 8 * fq;
#pragma unroll
        for (int ai = 0; ai < 2; ++ai)
#pragma unroll
            for (int m = 0; m < 4; ++m) {
                const int row = row0 + ai * 128 + m * 16;
                const float r = rsqrtf(ss[row] * (1.0f / D) + EPS);
                float o[8];
#pragma unroll
                for (int n = 0; n < 2; ++n)
#pragma unroll
                    for (int i = 0; i < 4; ++i) { const float g = acc[ai][0][m][n][i] * r, uu = acc[ai][1][m][n][i] * r; o[4 * n + i] = g * fast_sigmoid(g) * uu; }
                v4u w; w.x = pk(o[0], o[1]); w.y = pk(o[2], o[3]); w.z = pk(o[4], o[5]); w.w = pk(o[6], o[7]);
                *(v4u*)(O + (size_t)row * FF + col0) = w;
                if (m & 1) asm volatile("" ::: "memory");
            }
    }
};
struct EpiResid {
    static constexpr bool PERM = true, AFTER_DRAIN = false;
    const float* base; float* out; bf16* xb; float* ss_out; float scale;
    __device__ __forceinline__ void operator()(const f32x4 (&acc)[2][2][4][2], const pg8::Unit& u, int wr, int wc, int fr, int fq) const {
        const int row0 = u.pm * 256 + wr * 64 + fr, col0 = u.pn * 256 + wc * 32 + 8 * fq;
#pragma unroll
        for (int ai = 0; ai < 2; ++ai)
#pragma unroll
            for (int m = 0; m < 4; ++m) {
                const int row = row0 + ai * 128 + m * 16; float sq = 0.f;
#pragma unroll
                for (int bj = 0; bj < 2; ++bj) {
                    const size_t off = (size_t)row * D + col0 + bj * 128;
                    const f32x4 b0 = *(const f32x4*)(base + off), b1 = *(const f32x4*)(base + off + 4);
                    const f32x4 x0 = b0 + acc[ai][bj][m][0] * scale, x1 = b1 + acc[ai][bj][m][1] * scale;
                    *(f32x4*)(out + off) = x0; *(f32x4*)(out + off + 4) = x1;
                    v4u w; w.x = pk(x0[0], x0[1]); w.y = pk(x0[2], x0[3]); w.z = pk(x1[0], x1[1]); w.w = pk(x1[2], x1[3]);
                    *(v4u*)(xb + off) = w;
                    sq += (x0[0] * x0[0] + x0[1] * x0[1]) + (x0[2] * x0[2] + x0[3] * x0[3]) + (x1[0] * x1[0] + x1[1] * x1[1]) + (x1[2] * x1[2] + x1[3] * x1[3]);
                }
                sq += __shfl_xor(sq, 16); sq += __shfl_xor(sq, 32);
                if (fq == 0) unsafeAtomicAdd(ss_out + row, sq);
                asm volatile("" ::: "memory");
            }
    }
};
struct EpiMixIn {
    static constexpr bool PERM = true, AFTER_DRAIN = false;
    bf16* P; const float* ss; const float* cs;
    __device__ __forceinline__ void operator()(const f32x4 (&acc)[2][2][4][2], const pg8::Unit& u, int wr, int wc, int fr, int fq) const {
        const int row0 = u.pm * 256 + wr * 64 + fr, pn = u.pn, lc = wc * 32 + 8 * fq;
#pragma unroll
        for (int ai = 0; ai < 2; ++ai)
#pragma unroll
            for (int m = 0; m < 4; ++m) {
                const int row = row0 + ai * 128 + m * 16;
                const float r = rsqrtf(ss[row] * (1.0f / D) + EPS);
                f32x4 a0 = acc[ai][0][m][0] * r, a1 = acc[ai][0][m][1] * r, b0 = acc[ai][1][m][0] * r, b1 = acc[ai][1][m][1] * r;
                bf16* prow = P + (size_t)row * PW;
                if (pn >= 6 && pn < 10) {
                    float o[8];
#pragma unroll
                    for (int i = 0; i < 4; ++i) { o[i] = a0[i] * fast_sigmoid(b0[i]); o[4 + i] = a1[i] * fast_sigmoid(b1[i]); }
                    v4u w; w.x = pk(o[0], o[1]); w.y = pk(o[2], o[3]); w.z = pk(o[4], o[5]); w.w = pk(o[6], o[7]);
                    *(v4u*)(prow + 1536 + 128 * (pn - 6) + lc) = w;
                } else {
                    if (pn < 5) {
                        if ((wc & 1) == 0) {
                            f32x4 pa0, pa1, pb0, pb1;
#pragma unroll
                            for (int i = 0; i < 4; ++i) { pa0[i] = __shfl_xor(a0[i], 16); pa1[i] = __shfl_xor(a1[i], 16); pb0[i] = __shfl_xor(b0[i], 16); pb1[i] = __shfl_xor(b1[i], 16); }
                            if (fq < 2) {
                                const float* c = cs + (size_t)row * 16;
                                const f32x4 c0 = *(const f32x4*)c, c1 = *(const f32x4*)(c + 4); f32x4 s0 = *(const f32x4*)(c + 8), s1 = *(const f32x4*)(c + 12);
                                if (fq == 0) { s0 = -s0; s1 = -s1; }
                                a0 = a0 * c0 + pa0 * s0; a1 = a1 * c1 + pa1 * s1; b0 = b0 * c0 + pb0 * s0; b1 = b1 * c1 + pb1 * s1;
                            }
                        }
                        if (pn < 4) { a0 = a0 * 0.125f; a1 = a1 * 0.125f; b0 = b0 * 0.125f; b1 = b1 * 0.125f; }
                    }
                    const int cb = (pn <= 5 ? 256 * pn : 256 * pn - 512) + lc;
                    v4u w; w.x = pk(a0[0], a0[1]); w.y = pk(a0[2], a0[3]); w.z = pk(a1[0], a1[1]); w.w = pk(a1[2], a1[3]);
                    *(v4u*)(prow + cb) = w;
                    v4u z; z.x = pk(b0[0], b0[1]); z.y = pk(b0[2], b0[3]); z.z = pk(b1[0], b1[1]); z.w = pk(b1[2], b1[3]);
                    *(v4u*)(prow + cb + 128) = z;
                }
                asm volatile("" ::: "memory");
            }
    }
};

__device__ __forceinline__ void transpose_item(const float* W, int K, int N, const float* g, bf16* WT, int k0, int n0, int sn0, LAS float* scr, int lane) {
#pragma unroll
    for (int i = 0; i < 32; ++i) { const int kk = 2 * i + (lane >> 5); float w = W[(size_t)(k0 + kk) * N + sn0 + (lane & 31)]; if (g) w *= g[k0 + kk]; scr[kk * 33 + (lane & 31)] = w; }
    asm volatile("s_waitcnt lgkmcnt(0)" ::: "memory");
    const int c = lane & 7;
#pragma unroll
    for (int j = 0; j < 4; ++j) { const int n = (lane >> 3) + 8 * j; const LAS float* s = scr + (8 * c) * 33 + n;
        v4u o; o.x = pk(s[0 * 33], s[1 * 33]); o.y = pk(s[2 * 33], s[3 * 33]); o.z = pk(s[4 * 33], s[5 * 33]); o.w = pk(s[6 * 33], s[7 * 33]);
        *(v4u*)(WT + (size_t)(n0 + n) * K + k0 + 8 * c) = o; }
    asm volatile("s_waitcnt lgkmcnt(0)" ::: "memory");
}
__device__ __forceinline__ int src_col(int mode, int n0) {
    if (mode == 1) return ((n0 >> 7) & 1) * FF + 128 * (n0 >> 8) + (n0 & 127);
    if (mode == 2) { const int pn = n0 >> 8; if (pn >= 6 && pn < 10) return 1536 + 512 * ((n0 >> 7) & 1) + 128 * (pn - 6) + (n0 & 127); }
    return n0;
}
__device__ __forceinline__ void convert_matrix(const float* W, int K, int N, const float* g, bf16* WT, int mode, int item, LAS float* scr, int lane) {
    const int nblk = N / 32, kb = item / nblk, nb = item % nblk;
    transpose_item(W, K, N, g, WT, 64 * kb, 32 * nb, src_col(mode, 32 * nb), scr, lane);
}

struct Args {
    const float* x; const int* pos;
    const float *norm_ffn1, *ffn1_w_in, *ffn1_w_out, *norm_mix, *w_in, *conv_dw_w, *conv_dw_b, *conv_ln_g, *conv_ln_b, *sgu_ln_g, *sgu_ln_b, *sgu_w, *sgu_b, *attn_sinks, *w_out,
        *norm_ffn2, *ffn2_w_in, *ffn2_w_out, *final_norm;
    float* out; unsigned char* ws;
};

__device__ __forceinline__ void prologue(const Args& a, ldsp lds, int gw, int NGW, int lane, int wave) {
    LAS float* scr = (LAS float*)(lds + wave * 16384);
    constexpr int I_FI = (D / 64) * (NFF / 32), I_FO = (FF / 64) * (D / 32), I_IN = (D / 64) * (NIN / 32), I_OUT = (D / 64) * (D / 32);
    constexpr int I_LAYER = 2 * I_FI + 2 * I_FO + I_IN + I_OUT;
    for (int it = gw; it < 2 * I_LAYER; it += NGW) {
        const int l = it / I_LAYER; int r = it % I_LAYER;
        unsigned char* wl = a.ws + WS_W + (size_t)l * WL_SIZE;
        if (r < I_FI) { convert_matrix(a.ffn1_w_in + (size_t)l * D * NFF, D, NFF, a.norm_ffn1 + l * D, (bf16*)(wl + WL_F1I), 1, r, scr, lane); continue; } r -= I_FI;
        if (r < I_FI) { convert_matrix(a.ffn2_w_in + (size_t)l * D * NFF, D, NFF, a.norm_ffn2 + l * D, (bf16*)(wl + WL_F2I), 1, r, scr, lane); continue; } r -= I_FI;
        if (r < I_IN) { convert_matrix(a.w_in + (size_t)l * D * NIN, D, NIN, a.norm_mix + l * D, (bf16*)(wl + WL_IN), 2, r, scr, lane); continue; } r -= I_IN;
        if (r < I_FO) { convert_matrix(a.ffn1_w_out + (size_t)l * FF * D, FF, D, nullptr, (bf16*)(wl + WL_F1O), 0, r, scr, lane); continue; } r -= I_FO;
        if (r < I_FO) { convert_matrix(a.ffn2_w_out + (size_t)l * FF * D, FF, D, nullptr, (bf16*)(wl + WL_F2O), 0, r, scr, lane); continue; } r -= I_FO;
        convert_matrix(a.w_out + (size_t)l * D * D, D, D, nullptr, (bf16*)(wl + WL_OUT), 0, r, scr, lane);
    }
}

__device__ __forceinline__ void prologue_rows(const Args& a, int gw, int NGW, int lane, int gtid, int NGT) {
    bf16* XB = (bf16*)(a.ws + WS_XB); float* ss0 = (float*)(a.ws + WS_SS);
    for (int m = gw; m < M; m += NGW) {
        const f32x4* xr = (const f32x4*)(a.x + (size_t)m * D) + lane; v2u* o8 = (v2u*)(XB + (size_t)m * D) + lane; float s = 0.f;
#pragma unroll
        for (int j = 0; j < 8; ++j) { const f32x4 v = xr[64 * j]; s += (v[0] * v[0] + v[1] * v[1]) + (v[2] * v[2] + v[3] * v[3]); v2u w; w.x = pk(v[0], v[1]); w.y = pk(v[2], v[3]); o8[64 * j] = w; }
        s = wave_sum(s);
        if (lane == 0) ss0[m] = s;
    }
    for (int i = gtid; i < 6 * M; i += NGT) ss0[M + i] = 0.f;
    float* cs = (float*)(a.ws + WS_CS);
    for (int i = gtid; i < M * 8; i += NGT) {
        const int m = i >> 3, f = i & 7;
        const float invf[8] = {1.0f, 0.193922758102417f, 0.03760603070259094f, 0.00729266507551074f, 0.001414213445968926f, 0.00027424818836152554f, 5.318296462064609e-05f, 1.0313385246263351e-05f};
        float fr_ = invf[0];
#pragma unroll
        for (int k = 1; k < 8; ++k) fr_ = (f == k) ? invf[k] : fr_;
        const float ang = (float)a.pos[m] * fr_;
        double t = (double)ang * 0.15915494309189533577; t -= __builtin_rint(t);
        const float tf = (float)t;
        cs[(size_t)m * 16 + f] = __builtin_amdgcn_cosf(tf); cs[(size_t)m * 16 + 8 + f] = __builtin_amdgcn_sinf(tf);
    }
}

#define MFMA16(a, b, c) __builtin_amdgcn_mfma_f32_16x16x32_bf16(a, b, c, 0, 0, 0)

__device__ __forceinline__ void attn_unit(ldsp lds, const bf16* P, bf16* MX, const float* sinks, int b, int n, int g, int tid) {
    const int lane = tid & 63, wid = tid >> 6, fr = lane & 15, fq = lane >> 4;
    ldsp Kl = lds; ldsp Vl = lds + 36864;
    const int tok0 = b * SEQ + n * 128;
    const int hq = 4 * g + (wid >> 1), half = wid & 1;
    v4u kvr[4], vvr[4];
#pragma unroll
    for (int i = 0; i < 4; ++i) {
        const int p = tid + 512 * i, key = p >> 3, ch = p & 7;
        kvr[i] = (v4u){0u, 0u, 0u, 0u}; vvr[i] = (v4u){0u, 0u, 0u, 0u};
        if (n > 0 || key >= 128) { const bf16* src = P + (size_t)(tok0 - 128 + key) * PW + 64 * g + 8 * ch; kvr[i] = *(const v4u*)(src + 1024); vvr[i] = *(const v4u*)(src + 1280); }
    }
    const bf16* qbase = P + (size_t)(tok0 + 64 * half + fr) * PW + 64 * hq + 8 * fq;
    bf16x8 qn0 = *(const bf16x8*)qbase, qn1 = *(const bf16x8*)(qbase + 32);
    const float sink = sinks[hq];
#pragma unroll
    for (int i = 0; i < 4; ++i) {
        const int p = tid + 512 * i, key = p >> 3, ch = p & 7;
        *(LAS v4u*)(Kl + key * 144 + ch * 16) = kvr[i];
#pragma unroll
        for (int j = 0; j < 8; ++j) { const unsigned e = (vvr[i][j >> 1] >> (16 * (j & 1))) & 0xffffu; *(LAS unsigned short*)(Vl + (8 * ch + j) * 528 + key * 2) = (unsigned short)e; }
    }
    __syncthreads();
#pragma unroll 1
    for (int mt = 0; mt < 4; ++mt) {
        const int mp = 4 * half + mt;
        const bf16x8 q0 = qn0, q1 = qn1;
        { const bf16* qnx = qbase + (size_t)(16 * (mt < 3 ? mt + 1 : 3)) * PW; qn0 = *(const bf16x8*)qnx; qn1 = *(const bf16x8*)(qnx + 32); }
        f32x4 s[9];
#pragma unroll
        for (int kt = 0; kt < 9; ++kt) {
            ldsp kp = Kl + (16 * (mp + kt) + fr) * 144 + fq * 16;
            const bf16x8 k0 = *(const LAS bf16x8*)kp, k1 = *(const LAS bf16x8*)(kp + 64);
            f32x4 z = {0.f, 0.f, 0.f, 0.f};
            z = MFMA16(k0, q0, z); z = MFMA16(k1, q1, z); s[kt] = z;
        }
#pragma unroll
        for (int i = 0; i < 4; ++i) { if (!(4 * fq + i > fr)) s[0][i] = -1e30f; if (!(4 * fq + i <= fr)) s[8][i] = -1e30f; }
        if (n == 0) {
#pragma unroll
            for (int kt = 0; kt < 8; ++kt) if (mp + kt < 8) s[kt] = (f32x4){-1e30f, -1e30f, -1e30f, -1e30f};
        }
        float mx = sink;
#pragma unroll
        for (int kt = 0; kt < 9; ++kt) mx = fmaxf(mx, fmaxf(fmaxf(s[kt][0], s[kt][1]), fmaxf(s[kt][2], s[kt][3])));
        mx = fmaxf(mx, __shfl_xor(mx, 16)); mx = fmaxf(mx, __shfl_xor(mx, 32));
        float sum = 0.f; const float mxl = mx * LOG2E;
#pragma unroll
        for (int kt = 0; kt < 9; ++kt)
#pragma unroll
            for (int i = 0; i < 4; ++i) { const float p = __builtin_amdgcn_exp2f(s[kt][i] * LOG2E - mxl); s[kt][i] = p; sum += p; }
        sum += __shfl_xor(sum, 16); sum += __shfl_xor(sum, 32);
        sum += __builtin_amdgcn_exp2f(sink * LOG2E - mxl);
        const float inv = 1.0f / sum;
        f32x4 o[4];
#pragma unroll
        for (int nd = 0; nd < 4; ++nd) o[nd] = (f32x4){0.f, 0.f, 0.f, 0.f};
#pragma unroll
        for (int sp = 0; sp < 5; ++sp) {
            const int tA = mp + 2 * sp, tB = (sp < 4) ? tA + 1 : tA;
            v4u pw; pw.x = pk(s[2 * sp][0], s[2 * sp][1]); pw.y = pk(s[2 * sp][2], s[2 * sp][3]);
            const int iB = (sp < 4) ? 2 * sp + 1 : 8;
            if (sp < 4) { pw.z = pk(s[iB][0], s[iB][1]); pw.w = pk(s[iB][2], s[iB][3]); } else { pw.z = 0u; pw.w = 0u; }
            const bf16x8 pf = __builtin_bit_cast(bf16x8, pw);
#pragma unroll
            for (int nd = 0; nd < 4; ++nd) {
                ldsp vr = Vl + (16 * nd + fr) * 528 + 8 * fq;
                v4u vw; const v2u va = *(const LAS v2u*)(vr + 32 * tA), vb = *(const LAS v2u*)(vr + 32 * tB);
                vw.x = va.x; vw.y = va.y; vw.z = vb.x; vw.w = vb.y;
                o[nd] = MFMA16(__builtin_bit_cast(bf16x8, vw), pf, o[nd]);
            }
        }
        bf16* orow = MX + (size_t)(tok0 + 16 * mp + fr) * D + 64 * hq + 4 * fq;
#pragma unroll
        for (int nd = 0; nd < 4; ++nd) { v2u w; w.x = pk(o[nd][0] * inv, o[nd][1] * inv); w.y = pk(o[nd][2] * inv, o[nd][3] * inv); *(v2u*)(orow + 16 * nd) = w; }
    }
    __syncthreads();
}

typedef float f32x2 __attribute__((ext_vector_type(2)));
__device__ __forceinline__ void conv_unit(ldsp lds, const bf16* P, bf16* MX, const float* dw_w, const float* dw_b, const float* ln_g, const float* ln_b, int cu, int tid) {
    const int lane = tid & 63, wid = tid >> 6;
    const int tok0 = 32 * cu, s0 = tok0 & (SEQ - 1);
    ldsp Wl = lds + 65536;
    v4u st[8]; f32x4 sw[8];
#pragma unroll
    for (int i = 0; i < 8; ++i) {
        const int p = tid + NTHREADS * i, r = p >> 6, c = p & 63; st[i] = (v4u){0u, 0u, 0u, 0u};
        if (p < 3968 && s0 - 30 + r >= 0) st[i] = *(const v4u*)(P + (size_t)(tok0 - 30 + r) * PW + 1536 + 8 * c);
        sw[i] = (f32x4){0.f, 0.f, 0.f, 0.f};
        if (p < 3968) sw[i] = *(const f32x4*)(dw_w + 4 * p);
    }
#pragma unroll
    for (int i = 0; i < 8; ++i) {
        const int p = tid + NTHREADS * i, r = p >> 6, c = p & 63;
        if (p < 3968) { *(LAS v4u*)(lds + r * 1040 + c * 16) = st[i]; *(LAS f32x4*)(Wl + p * 16) = sw[i]; }
    }
    __syncthreads();
    const int c0 = 8 * lane;
    f32x2 acc[4][4];
#pragma unroll
    for (int t = 0; t < 4; ++t)
#pragma unroll
        for (int k = 0; k < 4; ++k) acc[t][k] = (f32x2){0.f, 0.f};
    ldsp rb = lds + (4 * wid) * 1040 + lane * 16; ldsp wb = Wl + lane * 32;
#pragma unroll 1
    for (int j = 0; j < 31; ++j) {
        const f32x4 w0 = *(const LAS f32x4*)(wb + j * 2048), w1 = *(const LAS f32x4*)(wb + j * 2048 + 16);
        const f32x2 wv[4] = {{w0[0], w0[1]}, {w0[2], w0[3]}, {w1[0], w1[1]}, {w1[2], w1[3]}};
#pragma unroll
        for (int t = 0; t < 4; ++t) {
            const v4u hv = *(const LAS v4u*)(rb + (t + j) * 1040);
#pragma unroll
            for (int k = 0; k < 4; ++k) { const f32x2 h2 = {bflo(hv[k]), bfhi(hv[k])}; acc[t][k] += h2 * wv[k]; }
        }
    }
    const f32x4 bb0 = *(const f32x4*)(dw_b + c0), bb1 = *(const f32x4*)(dw_b + c0 + 4), g0 = *(const f32x4*)(ln_g + c0), g1 = *(const f32x4*)(ln_g + c0 + 4), e0 = *(const f32x4*)(ln_b + c0), e1 = *(const f32x4*)(ln_b + c0 + 4);
#pragma unroll
    for (int t = 0; t < 4; ++t) {
        f32x4 y0 = (f32x4){acc[t][0][0], acc[t][0][1], acc[t][1][0], acc[t][1][1]} + bb0, y1 = (f32x4){acc[t][2][0], acc[t][2][1], acc[t][3][0], acc[t][3][1]} + bb1;
        const float s = (y0[0] + y0[1]) + (y0[2] + y0[3]) + (y1[0] + y1[1]) + (y1[2] + y1[3]);
        const float mean = wave_sum(s) * (1.0f / 512.0f);
        y0 = y0 - mean; y1 = y1 - mean;
        const float q = (y0[0] * y0[0] + y0[1] * y0[1]) + (y0[2] * y0[2] + y0[3] * y0[3]) + (y1[0] * y1[0] + y1[1] * y1[1]) + (y1[2] * y1[2] + y1[3] * y1[3]);
        const float rstd = __builtin_amdgcn_rsqf(wave_sum(q) * (1.0f / 512.0f) + EPS);
        y0 = y0 * rstd * g0 + e0; y1 = y1 * rstd * g1 + e1;
#pragma unroll
        for (int c = 0; c < 4; ++c) { y0[c] = y0[c] * fast_sigmoid(y0[c]); y1[c] = y1[c] * fast_sigmoid(y1[c]); }
        v4u w; w.x = pk(y0[0], y0[1]); w.y = pk(y0[2], y0[3]); w.z = pk(y1[0], y1[1]); w.w = pk(y1[2], y1[3]);
        *(v4u*)(MX + (size_t)(tok0 + 4 * wid + t) * D + 1024 + c0) = w;
    }
    __syncthreads();
}

__device__ __forceinline__ void sgu_unit(ldsp lds, const bf16* P, bf16* MX, const float* ln_g, const float* ln_b, const float* w_s, const float* b_s, int ck, int hf, int tid) {
    const int lane = tid & 63, wid = tid >> 6, fr = lane & 15, fq = lane >> 4;
    const int tok0 = 128 * ck, c0 = 8 * lane;
    const int hl = wid >> 1, hh = 4 * hf + hl, th = wid & 1;
    {
        const f32x4 g0 = *(const f32x4*)(ln_g + c0), g1 = *(const f32x4*)(ln_g + c0 + 4), e0 = *(const f32x4*)(ln_b + c0), e1 = *(const f32x4*)(ln_b + c0 + 4);
#pragma unroll 1
        for (int i4 = 0; i4 < 16; i4 += 4) {
        v4u raw4[4];
#pragma unroll
        for (int i = 0; i < 4; ++i) raw4[i] = *(const v4u*)(P + (size_t)(tok0 + 16 * wid + i4 + i) * PW + 2560 + c0);
#pragma unroll
        for (int i = 0; i < 4; ++i) {
            const int sidx = 16 * wid + i4 + i; const v4u rw = raw4[i];
            float v[8] = {bflo(rw.x), bfhi(rw.x), bflo(rw.y), bfhi(rw.y), bflo(rw.z), bfhi(rw.z), bflo(rw.w), bfhi(rw.w)};
            float s = 0.f;
#pragma unroll
            for (int c = 0; c < 8; ++c) s += v[c];
            const float mean = wave_sum(s) * (1.0f / 512.0f); float q = 0.f;
#pragma unroll
            for (int c = 0; c < 8; ++c) { v[c] -= mean; q += v[c] * v[c]; }
            const float rstd = __builtin_amdgcn_rsqf(wave_sum(q) * (1.0f / 512.0f) + EPS);
            if ((lane >> 5) == hf) {
#pragma unroll
                for (int c = 0; c < 8; ++c) { const float vn = v[c] * rstd * (c < 4 ? g0[c & 3] : g1[c & 3]) + (c < 4 ? e0[c & 3] : e1[c & 3]);
                    *(LAS unsigned short*)(lds + ((c0 & 255) + c) * 272 + 2 * sidx) = (unsigned short)(pk(vn, 0.f) & 0xffffu); }
            }
        }
        }
    }
    __syncthreads();
#pragma unroll 1
    for (int m = 0; m < 4; ++m) {
        const int t0 = 64 * th + 16 * m, t = t0 + fr;
        f32x4 acc[4];
#pragma unroll
        for (int nd = 0; nd < 4; ++nd) acc[nd] = (f32x4){0.f, 0.f, 0.f, 0.f};
        const float* wrow = w_s + ((size_t)hh * 128 + t) * 128;
        const int nks = (t0 + 15) / 32 + 1;
        f32x4 wa[4], wb[4];
#pragma unroll
        for (int ks = 0; ks < 4; ++ks) { const int kk = ks < nks ? ks : 0; wa[ks] = *(const f32x4*)(wrow + 32 * kk + 8 * fq); wb[ks] = *(const f32x4*)(wrow + 32 * kk + 8 * fq + 4); }
        const float bias = b_s[hh * 128 + t];
        v2u uu[4];
#pragma unroll
        for (int nd = 0; nd < 4; ++nd) uu[nd] = *(const v2u*)(P + (size_t)(tok0 + t) * PW + 2048 + 64 * hh + 16 * nd + 4 * fq);
#pragma unroll
        for (int ks = 0; ks < 4; ++ks) {
            if (ks < nks) {
                const int sb = 32 * ks + 8 * fq;
                f32x4 xa = wa[ks], xb = wb[ks];
#pragma unroll
                for (int i = 0; i < 4; ++i) { xa[i] = (sb + i <= t) ? xa[i] : 0.f; xb[i] = (sb + 4 + i <= t) ? xb[i] : 0.f; }
                v4u ww; ww.x = pk(xa[0], xa[1]); ww.y = pk(xa[2], xa[3]); ww.z = pk(xb[0], xb[1]); ww.w = pk(xb[2], xb[3]);
                const bf16x8 wf = __builtin_bit_cast(bf16x8, ww);
#pragma unroll
                for (int nd = 0; nd < 4; ++nd) {
                    const bf16x8 vf = *(const LAS bf16x8*)(lds + (64 * hl + 16 * nd + fr) * 272 + 64 * ks + 16 * fq);
                    acc[nd] = MFMA16(vf, wf, acc[nd]);
                }
            }
        }
#pragma unroll
        for (int nd = 0; nd < 4; ++nd) {
            const int ch = 64 * hh + 16 * nd + 4 * fq;
            v2u w; w.x = pk((acc[nd][0] + bias) * bflo(uu[nd].x), (acc[nd][1] + bias) * bfhi(uu[nd].x)); w.y = pk((acc[nd][2] + bias) * bflo(uu[nd].y), (acc[nd][3] + bias) * bfhi(uu[nd].y));
            *(v2u*)(MX + (size_t)(tok0 + t) * D + 1536 + ch) = w;
        }
    }
    __syncthreads();
}

#define XB_TMO      128
#define XB_XCNT(j)  (256  + 64 * (j))
#define XB_XSUB(j)  (1280 + 64 * (j))
#define XB_XGEN(j)  (2304 + 64 * (j))
#define XB_TOP      3328
#define XB_TOPGEN   3392
#define XCD_BAR_WORDS 3456
#define XB_SPIN_CAP (1u << 23)

__device__ __forceinline__ unsigned xb_ld(unsigned* p)              { return __hip_atomic_load(p, __ATOMIC_RELAXED, __HIP_MEMORY_SCOPE_AGENT); }
__device__ __forceinline__ unsigned xb_add(unsigned* p, unsigned v) { return __hip_atomic_fetch_add(p, v, __ATOMIC_RELAXED, __HIP_MEMORY_SCOPE_AGENT); }
__device__ __forceinline__ unsigned xb_xcc_id() { return (unsigned)__builtin_amdgcn_s_getreg((3 << 11) | 20) & 0xFu; }
#define XB_SPIN(cond, bar) do { unsigned _sp = 0; while (cond) { __builtin_amdgcn_s_sleep(1); \
    if ((++_sp & 255u) == 0u) { if (xb_ld(&(bar)[XB_TMO])) break; if (_sp > XB_SPIN_CAP) { atomicAdd(&(bar)[XB_TMO], 1u); break; } } } } while (0)

struct XcdBarrier {
    unsigned* bar; unsigned x;
    volatile LAS unsigned* st;
};

__device__ __forceinline__ XcdBarrier xcd_barrier_post(unsigned* bar, volatile LAS unsigned* st) {
    XcdBarrier b; b.bar = bar; b.x = xb_xcc_id(); b.st = st;
    if (threadIdx.x == 0) (void)xb_add(&bar[XB_XCNT(b.x)], 1u);
    return b;
}
__device__ __forceinline__ void xcd_barrier_complete(unsigned* bar, unsigned x, unsigned& nloc, unsigned& nx) {
    const unsigned G = gridDim.x * gridDim.y * gridDim.z;
    unsigned sum, cnt, mine, sp = 0u;
    for (;;) {
        sum = 0u; cnt = 0u; mine = 0u;
#pragma unroll
        for (unsigned j = 0; j < 16; ++j) { const unsigned c = xb_ld(&bar[XB_XCNT(j)]); sum += c; cnt += (c > 0u) ? 1u : 0u; mine = (j == x) ? c : mine; }
        if (sum == G) break;
        __builtin_amdgcn_s_sleep(1);
        if ((++sp & 255u) == 0u) { if (xb_ld(&bar[XB_TMO])) break; if (sp > XB_SPIN_CAP) { atomicAdd(&bar[XB_TMO], 1u); break; } }
    }
    nloc = mine > 0u ? mine : 1u; nx = cnt > 0u ? cnt : 1u;
}

__device__ __forceinline__ void xcd_barrier(const XcdBarrier& b) {
    asm volatile("s_waitcnt vmcnt(0)" ::: "memory");
    __syncthreads();
    if (threadIdx.x == 0) {
        unsigned* bar = b.bar;
        __builtin_amdgcn_s_waitcnt(0);
        unsigned nloc = b.st[0], nx = b.st[1];
        if (nloc == 0u) { xcd_barrier_complete(bar, b.x, nloc, nx); b.st[0] = nloc; b.st[1] = nx; }
        const unsigned old = xb_add(&bar[XB_XSUB(b.x)], 1u);
        const unsigned gen = old / nloc;
        if (old + 1u == (gen + 1u) * nloc) {
            __builtin_amdgcn_fence(__ATOMIC_RELEASE, "agent");
            asm volatile("s_waitcnt vmcnt(0)" ::: "memory");
            const unsigned og = xb_add(&bar[XB_TOP], 1u);
            const unsigned tg = og / nx;
            if (og + 1u == (tg + 1u) * nx) xb_add(&bar[XB_TOPGEN], 1u);
            else XB_SPIN(xb_ld(&bar[XB_TOPGEN]) == tg, bar);
            __builtin_amdgcn_fence(__ATOMIC_ACQUIRE, "agent");
            xb_add(&bar[XB_XGEN(b.x)], 1u);
            asm volatile("s_waitcnt vmcnt(0)" ::: "memory");
        } else {
            XB_SPIN(xb_ld(&bar[XB_XGEN(b.x)]) == gen, bar);
            __builtin_amdgcn_fence(__ATOMIC_ACQUIRE, "agent");
            asm volatile("s_waitcnt vmcnt(0)" ::: "memory");
        }
    }
    __syncthreads();
}

typedef const __attribute__((address_space(4))) Args* kargp;
__device__ __forceinline__ kargp kargs() { kargp p = (kargp)__builtin_amdgcn_kernarg_segment_ptr(); asm volatile("" : "+s"(p)); return p; }
__global__ void __launch_bounds__(NTHREADS, 2) fwd_megakernel(Args a_unused) {
    extern __shared__ __attribute__((aligned(16))) unsigned char lds_raw[];
    cg::grid_group grid = cg::this_grid();
    ldsp lds = (ldsp)lds_raw;
    const int tid = threadIdx.x, lane = tid & 63, wave = __builtin_amdgcn_readfirstlane(tid >> 6);
    const int G = gridDim.x, bid = blockIdx.x;
    const int gw = bid * NWAVES + wave, NGW = G * NWAVES, gtid = bid * NTHREADS + tid, NGT = G * NTHREADS;
    unsigned char* ws = kargs()->ws;

#ifndef PROBE_PRO
#define PROBE_PRO 1
#endif
#ifndef PROBE_MIX
#define PROBE_MIX 1
#endif
#ifndef PROBE_FFI
#define PROBE_FFI 1
#endif
    volatile LAS unsigned* bar_st = (volatile LAS unsigned*)(lds + LDS_BYTES - 64);
    if (tid < 2) bar_st[tid] = 0u;
    if (bid == 0) { unsigned* bw = (unsigned*)a_unused.ws; for (int i = tid; i < XCD_BAR_WORDS; i += NTHREADS) bw[i] = 0u; }
    for (int rep = 0; rep < PROBE_PRO; ++rep) prologue(a_unused, lds, gw, NGW, lane, wave);
    prologue_rows(a_unused, gw, NGW, lane, gtid, NGT);
    grid.sync();
    const XcdBarrier xbar = xcd_barrier_post((unsigned*)ws, bar_st);

    for (int step = 0; step < 6; ++step) {
        const int l = step / 3, sub = step % 3;
        ws = kargs()->ws; const unsigned char* wl = ws + WS_W + (size_t)l * WL_SIZE;
        float* ssb = (float*)(ws + WS_SS); const float* cs = (const float*)(ws + WS_CS);
        bf16* XB = (bf16*)(ws + WS_XB); bf16* ACT = (bf16*)(ws + WS_ACT); bf16* PB = (bf16*)(ws + WS_P); bf16* MX = (bf16*)(ws + WS_MX);
        const float* ss_in = ssb + (size_t)step * M; float* ss_out = ssb + (size_t)(step + 1) * M;
        const bf16* A2; const bf16* B2; int K2; float scale;
        if (sub != 1) {
            pg8::Gemm g{XB, (const bf16*)(wl + (sub == 0 ? WL_F1I : WL_F2I)), M, NFF, D}; pg8::StaticOrder S; S.init(M, NFF, G, bid);
            EpiSwiGLU E{ACT, ss_in};
            for (int rep = 0; rep < PROBE_FFI; ++rep) pg8::gemm_phase<EpiSwiGLU, pg8::StaticOrder, true, true>(lds, g, S, E);
            xcd_barrier(xbar);
            A2 = ACT; B2 = (const bf16*)(wl + (sub == 0 ? WL_F1O : WL_F2O)); K2 = FF; scale = 0.5f;
        } else {
            {
                pg8::Gemm g{XB, (const bf16*)(wl + WL_IN), M, NIN, D}; pg8::StaticOrder S; S.init(M, NIN, G, bid);
                EpiMixIn E{PB, ss_in, cs};
                pg8::gemm_phase<EpiMixIn, pg8::StaticOrder, true, true>(lds, g, S, E);
            }
            xcd_barrier(xbar);
            for (int rep = 0; rep < PROBE_MIX; ++rep)
            for (int u = bid; u < 1280; u += G) {
                kargp a = kargs(); int tl = threadIdx.x; asm volatile("" : "+v"(tl));
                if (u < 512) attn_unit(lds, PB, MX, a->attn_sinks + l * 16, u >> 7, (u & 127) >> 2, u & 3, tl);
                else if (u < 1024) conv_unit(lds, PB, MX, a->conv_dw_w + (size_t)l * 31 * 512, a->conv_dw_b + l * 512, a->conv_ln_g + l * 512, a->conv_ln_b + l * 512, u - 512, tl);
                else sgu_unit(lds, PB, MX, a->sgu_ln_g + l * 512, a->sgu_ln_b + l * 512, a->sgu_w + (size_t)l * 8 * 128 * 128, a->sgu_b + l * 8 * 128, (u - 1024) >> 1, (u - 1024) & 1, tl);
            }
            xcd_barrier(xbar);
            A2 = MX; B2 = (const bf16*)(wl + WL_OUT); K2 = D; scale = 1.0f;
        }
        {
            pg8::Gemm g{A2, B2, M, D, K2}; pg8::StaticOrder S; S.init(M, D, G, bid);
            kargp a = kargs(); float* outp = a->out;
            EpiResid E{step == 0 ? a->x : (const float*)outp, outp, XB, ss_out, scale};
            pg8::gemm_phase<EpiResid, pg8::StaticOrder, true, true>(lds, g, S, E);
        }
        xcd_barrier(xbar);
    }
    {
        kargp a = kargs(); const float* ss = (const float*)(a->ws + WS_SS) + (size_t)6 * M; float* outp = a->out; const float* fng = a->final_norm;
        for (int m = gw; m < M; m += NGW) {
            const float r = rsqrtf(ss[m] * (1.0f / D) + EPS);
            f32x4* xr = (f32x4*)(outp + (size_t)m * D) + lane; const f32x4* gr = (const f32x4*)fng + lane;
#pragma unroll
            for (int j = 0; j < 8; ++j) { const f32x4 v = xr[64 * j], gg = gr[64 * j]; xr[64 * j] = v * r * gg; }
        }
    }
}

extern "C" void kernel_launch(void* const* d_in, const int* in_sizes, int n_in, void* d_out, int out_size, void* d_ws, size_t ws_size, hipStream_t stream) {
    static int grid_blocks = 0;
    if (grid_blocks == 0) {
        if (n_in != 21 || out_size != M * D || ws_size < WS_END) { fprintf(stderr, "kernel_launch: unexpected shapes (n_in %d out %d ws %zu need %zu)\n", n_in, out_size, ws_size, (size_t)WS_END); grid_blocks = -1; return; }
        int dev = 0, cus = 0, per_cu = 0;
        (void)hipGetDevice(&dev);
        (void)hipDeviceGetAttribute(&cus, hipDeviceAttributeMultiprocessorCount, dev);
        if (hipFuncSetAttribute((const void*)fwd_megakernel, hipFuncAttributeMaxDynamicSharedMemorySize, LDS_BYTES) != hipSuccess) { fprintf(stderr, "kernel_launch: hipFuncSetAttribute failed\n"); grid_blocks = -1; return; }
        if (hipOccupancyMaxActiveBlocksPerMultiprocessor(&per_cu, (const void*)fwd_megakernel, NTHREADS, LDS_BYTES) != hipSuccess || per_cu < 1) { fprintf(stderr, "kernel_launch: occupancy query says %d\n", per_cu); per_cu = 1; (void)hipGetLastError(); }
        grid_blocks = cus * per_cu;
    }
    if (grid_blocks < 0) return;
    Args a{};
    a.x = (const float*)d_in[0]; a.pos = (const int*)d_in[1];
    a.norm_ffn1 = (const float*)d_in[2]; a.ffn1_w_in = (const float*)d_in[3]; a.ffn1_w_out = (const float*)d_in[4]; a.norm_mix = (const float*)d_in[5]; a.w_in = (const float*)d_in[6];
    a.conv_dw_w = (const float*)d_in[7]; a.conv_dw_b = (const float*)d_in[8]; a.conv_ln_g = (const float*)d_in[9]; a.conv_ln_b = (const float*)d_in[10];
    a.sgu_ln_g = (const float*)d_in[11]; a.sgu_ln_b = (const float*)d_in[12]; a.sgu_w = (const float*)d_in[13]; a.sgu_b = (const float*)d_in[14]; a.attn_sinks = (const float*)d_in[15];
    a.w_out = (const float*)d_in[16]; a.norm_ffn2 = (const float*)d_in[17]; a.ffn2_w_in = (const float*)d_in[18]; a.ffn2_w_out = (const float*)d_in[19]; a.final_norm = (const float*)d_in[20];
    a.out = (float*)d_out; a.ws = (unsigned char*)d_ws;
    void* args[] = {&a};
    hipError_t e = hipLaunchCooperativeKernel((const void*)fwd_megakernel, dim3(grid_blocks), dim3(NTHREADS), args, LDS_BYTES, stream);
    if (e != hipSuccess) fprintf(stderr, "kernel_launch: cooperative launch failed: %s (grid %d)\n", hipGetErrorString(e), grid_blocks);
}
```

```cpp
#include <hip/hip_runtime.h>
#include <hip/hip_cooperative_groups.h>
#include <cstdio>
#include <cstdint>
namespace cg = cooperative_groups;
namespace pg8 {
#define PG8_LAS __attribute__((address_space(3)))
typedef unsigned short bf16_t;
typedef short bf16x8 __attribute__((ext_vector_type(8)));
typedef float f32x4 __attribute__((ext_vector_type(4)));
typedef unsigned u32x4 __attribute__((ext_vector_type(4)));
constexpr int BM = 256, BK = 64, HALF = 128, HTB = HALF * BK * 2  , STAGE_BYTES = 8 * HTB, NXCD = 8, WGM = 8;

__host__ __device__ __forceinline__ int lds_byte(int r, int c) { const int st = (r >> 4) * 2 + (c >> 5), rr = r & 15, cc = c & 31, ob = rr * 64 + cc * 2; return st * 1024 + (ob ^ (((ob >> 9) & 1) << 5)); }
__host__ __device__ __forceinline__ void stage_rc(int b, int& R, int& C) { const int st = b / 1024, sb = b % 1024, swz = sb ^ (((sb >> 9) & 1) << 5); R = (st >> 1) * 16 + swz / 64; C = (st & 1) * 32 + (swz % 64) / 2; }
__host__ __device__ __forceinline__ int perm32(int rho) { const int n = rho >> 4, i = rho & 15; return 8 * (i >> 2) + 4 * n + (i & 3); }

struct Unit { int pm, pn; };
struct Gemm { const bf16_t* A; const bf16_t* Bt; int M, N, K; };

struct StaticOrder {
    int nM, nN, nwg, G, c;
    __host__ __device__ void init(int M, int N, int G_, int c_) { nM = M / BM; nN = N / BM; nwg = nM * nN; G = G_; c = c_; }
    __host__ __device__ bool next(int i, Unit& u) const {
        const long L = (long)i * G + c; if (L >= nwg) return false;
        int wgid = (int)L; { const int q = nwg / NXCD, r = nwg % NXCD, xcd = wgid % NXCD, off = wgid / NXCD; wgid = (xcd < r ? xcd * (q + 1) : r * (q + 1) + (xcd - r) * q) + off; }
        const int nig = WGM * nN, gid = wgid / nig, fm = gid * WGM, gsz = (nM - fm) < WGM ? (nM - fm) : WGM;
        u.pm = fm + ((wgid % nig) % gsz); u.pn = (wgid % nig) / gsz; return true;
    }
    __device__ __forceinline__ void a_ready(const Unit&) const {}
    __device__ __forceinline__ void done(const Unit&) const {}
};

__device__ __forceinline__ unsigned cvt_pk_bf16(float lo, float hi) { unsigned r; asm volatile("v_cvt_pk_bf16_f32 %0, %1, %2" : "=v"(r) : "v"(lo), "v"(hi)); return r; }
typedef float f32x2 __attribute__((ext_vector_type(2)));
template <class Epi, class Sched, bool ALIGN_EPI = false, bool SP2 = false>
__device__ __forceinline__ void gemm_phase(PG8_LAS unsigned char* lds, const Gemm g, const Sched& S, const Epi& E) {
    int tid_ = threadIdx.x; asm volatile("" : "+v"(tid_));
    const int tid = tid_, wid = __builtin_amdgcn_readfirstlane(tid >> 6), lane = tid & 63, wr = wid >> 2, wc = wid & 3, fr = lane & 15, fq = lane >> 4;
    const int K = g.K, nt = K / BK;
    unsigned voffA[2], voffB[2];
#pragma unroll
    for (int i = 0; i < 2; ++i) { int R, C; stage_rc(tid * 16 + i * 8192, R, C); const int Rb = Epi::PERM ? ((R & ~31) + perm32(R & 31)) : R;
        voffA[i] = (unsigned)(R * K + C) * 2u; voffB[i] = (unsigned)(Rb * K + C) * 2u; }
    const size_t kstep = (size_t)(BK * 2);
    const size_t hstep = (size_t)HALF * K * 2;
    const size_t tstep = 2 * hstep;
    const unsigned ldsw = (unsigned)wid * 1024u;
    const int aoff = lds_byte(wr * 64 + fr, fq * 8), boff = lds_byte(wc * 32 + fr, fq * 8);
#define PG8_SA(b, h) (((b) * 2 + (h)) * HTB)
#define PG8_SB(b, h) ((4 + (b) * 2 + (h)) * HTB)
#define PG8_STAGE(bufoff, gbase, voff) do { _Pragma("unroll") for (int _i = 0; _i < 2; ++_i) \
        __builtin_amdgcn_global_load_lds((const unsigned*)((const char*)(gbase) + (voff)[_i]), (PG8_LAS unsigned*)(lds + (bufoff) + ldsw + _i * 8192), 16, 0, 0); } while (0)
#define PG8_LDA(dst, b, h) do { _Pragma("unroll") for (int m = 0; m < 4; ++m) _Pragma("unroll") for (int k = 0; k < 2; ++k) dst[m][k] = *(const PG8_LAS bf16x8*)(lds + PG8_SA(b, h) + aoff + m * 2048 + k * 1024); } while (0)
#define PG8_LDB(dst, b, h) do { _Pragma("unroll") for (int n = 0; n < 2; ++n) _Pragma("unroll") for (int k = 0; k < 2; ++k) dst[n][k] = *(const PG8_LAS bf16x8*)(lds + PG8_SB(b, h) + boff + n * 2048 + k * 1024); } while (0)
#define PG8_MMA(ai, bj, At, Bt) do { __builtin_amdgcn_s_setprio(1); _Pragma("unroll") for (int m = 0; m < 4; ++m) _Pragma("unroll") for (int n = 0; n < 2; ++n) _Pragma("unroll") for (int k = 0; k < 2; ++k) \
        acc[ai][bj][m][n] = __builtin_amdgcn_mfma_f32_16x16x32_bf16(Bt[n][k], At[m][k], acc[ai][bj][m][n], 0, 0, 0); __builtin_amdgcn_s_setprio(0); } while (0)
#define PG8_WAIT_V(n) asm volatile("s_waitcnt vmcnt(" #n ")" ::: "memory")
#define PG8_WAIT_L(n) asm volatile("s_waitcnt lgkmcnt(" #n ")" ::: "memory")
#define PG8_BAR __builtin_amdgcn_s_barrier()
#define PG8_SCHED __builtin_amdgcn_sched_barrier(0)
    Unit cur, nxt; int ui = 0;
    if (!S.next(0, cur)) return;
    f32x4 acc[2][2][4][2];
#pragma unroll
    for (int a = 0; a < 2; ++a)
#pragma unroll
        for (int b = 0; b < 2; ++b)
#pragma unroll
            for (int m = 0; m < 4; ++m)
#pragma unroll
                for (int n = 0; n < 2; ++n) acc[a][b][m][n] = (f32x4){0.f, 0.f, 0.f, 0.f};
    bf16x8 At[4][2], B0[2][2], B1[2][2];
    const char* cA = (const char*)g.A + (size_t)cur.pm * tstep; const char* cB = (const char*)g.Bt + (size_t)cur.pn * tstep;
    S.a_ready(cur);
    if constexpr (SP2) {
        PG8_STAGE(PG8_SB(0, 0), cB, voffB); PG8_STAGE(PG8_SB(0, 1), cB + hstep, voffB); PG8_STAGE(PG8_SA(0, 0), cA, voffA); PG8_STAGE(PG8_SA(0, 1), cA + hstep, voffA);
        if (wr == 1) PG8_BAR;
        PG8_WAIT_V(2); PG8_BAR;
        PG8_STAGE(PG8_SB(1, 0), cB + kstep, voffB); PG8_STAGE(PG8_SA(1, 0), cA + kstep, voffA); PG8_STAGE(PG8_SB(1, 1), cB + hstep + kstep, voffB);
        PG8_WAIT_V(6); PG8_BAR;
    } else {
        PG8_STAGE(PG8_SB(0, 0), cB, voffB); PG8_STAGE(PG8_SA(0, 0), cA, voffA); PG8_STAGE(PG8_SB(0, 1), cB + hstep, voffB); PG8_STAGE(PG8_SA(0, 1), cA + hstep, voffA);
        if (wr == 1) PG8_BAR;
        PG8_WAIT_V(4); PG8_BAR;
        PG8_STAGE(PG8_SB(1, 0), cB + kstep, voffB); PG8_STAGE(PG8_SA(1, 0), cA + kstep, voffA); PG8_STAGE(PG8_SB(1, 1), cB + hstep + kstep, voffB);
        PG8_WAIT_V(6); PG8_BAR;
    }
    for (;;) {
        const bool has_next = S.next(ui + 1, nxt);
        const char* nA = has_next ? (const char*)g.A + (size_t)nxt.pm * tstep : cA; const char* nB = has_next ? (const char*)g.Bt + (size_t)nxt.pn * tstep : cB;
        for (int t = 0; t < nt; t += 2) {
            const bool last = (t == nt - 2);
            const char* a1 = cA + (size_t)(t + 1) * kstep;
            const char* a2 = last ? nA : cA + (size_t)(t + 2) * kstep; const char* b2 = last ? nB : cB + (size_t)(t + 2) * kstep;
            const char* a3 = a2 + kstep; const char* b3 = b2 + kstep;
            if (last && has_next) S.a_ready(nxt);
            if constexpr (SP2) {
            PG8_LDB(B0, 0, 0); PG8_LDB(B1, 0, 1); PG8_SCHED; PG8_LDA(At, 0, 0); PG8_STAGE(PG8_SA(1, 1), a1 + hstep, voffA);
            PG8_WAIT_V(8); PG8_WAIT_L(0); PG8_BAR; PG8_MMA(0, 0, At, B0); PG8_MMA(0, 1, At, B1); PG8_BAR; PG8_SCHED;
            PG8_LDA(At, 0, 1); PG8_STAGE(PG8_SB(0, 0), b2, voffB); PG8_STAGE(PG8_SB(0, 1), b2 + hstep, voffB); PG8_STAGE(PG8_SA(0, 0), a2, voffA);
            PG8_WAIT_V(8); PG8_WAIT_L(0); PG8_BAR; PG8_MMA(1, 0, At, B0); PG8_MMA(1, 1, At, B1); PG8_BAR; PG8_SCHED;
            PG8_LDB(B0, 1, 0); PG8_LDB(B1, 1, 1); PG8_SCHED; PG8_LDA(At, 1, 0); PG8_STAGE(PG8_SA(0, 1), a2 + hstep, voffA);
            PG8_WAIT_V(8); PG8_WAIT_L(0); PG8_BAR; PG8_MMA(0, 0, At, B0); PG8_MMA(0, 1, At, B1); PG8_BAR; PG8_SCHED;
            PG8_LDA(At, 1, 1); PG8_STAGE(PG8_SB(1, 0), b3, voffB); PG8_STAGE(PG8_SB(1, 1), b3 + hstep, voffB); PG8_STAGE(PG8_SA(1, 0), a3, voffA);
            PG8_WAIT_V(8); PG8_WAIT_L(0); PG8_BAR; PG8_MMA(1, 0, At, B0); PG8_MMA(1, 1, At, B1); PG8_BAR; PG8_SCHED;
            } else {
            PG8_LDB(B0, 0, 0); PG8_SCHED; PG8_LDA(At, 0, 0); PG8_STAGE(PG8_SA(1, 1), a1 + hstep, voffA);
            PG8_WAIT_L(8); PG8_BAR; PG8_WAIT_L(0); PG8_MMA(0, 0, At, B0); PG8_BAR; PG8_SCHED;
            PG8_LDB(B1, 0, 1); PG8_STAGE(PG8_SB(0, 0), b2, voffB);
            PG8_BAR; PG8_WAIT_L(0); PG8_MMA(0, 1, At, B1); PG8_BAR;
            PG8_LDA(At, 0, 1); PG8_STAGE(PG8_SA(0, 0), a2, voffA);
            PG8_BAR; PG8_WAIT_L(0); PG8_MMA(1, 0, At, B0); PG8_BAR; PG8_SCHED;
            PG8_STAGE(PG8_SB(0, 1), b2 + hstep, voffB);
            PG8_WAIT_V(6); PG8_BAR; PG8_MMA(1, 1, At, B1); PG8_BAR;
            PG8_LDB(B0, 1, 0); PG8_SCHED; PG8_LDA(At, 1, 0); PG8_STAGE(PG8_SA(0, 1), a2 + hstep, voffA);
            PG8_WAIT_L(8); PG8_BAR; PG8_WAIT_L(0); PG8_MMA(0, 0, At, B0); PG8_BAR; PG8_SCHED;
            PG8_LDB(B1, 1, 1); PG8_STAGE(PG8_SB(1, 0), b3, voffB);
            PG8_BAR; PG8_WAIT_L(0); PG8_MMA(0, 1, At, B1); PG8_BAR;
            PG8_LDA(At, 1, 1); PG8_STAGE(PG8_SA(1, 0), a3, voffA);
            PG8_BAR; PG8_WAIT_L(0); PG8_MMA(1, 0, At, B0); PG8_BAR; PG8_SCHED;
            PG8_STAGE(PG8_SB(1, 1), b3 + hstep, voffB);
            PG8_WAIT_V(6); PG8_BAR; PG8_MMA(1, 1, At, B1); PG8_BAR;
            }
        }
        if constexpr (ALIGN_EPI) { if (wr == 0) PG8_BAR; }
        if constexpr (!Epi::AFTER_DRAIN) { E(acc, cur, wr, wc, fr, fq); S.done(cur); }
        if (!has_next) break;
#pragma unroll
        for (int a = 0; a < 2; ++a)
#pragma unroll
            for (int b = 0; b < 2; ++b)
#pragma unroll
                for (int m = 0; m < 4; ++m)
#pragma unroll
                    for (int n = 0; n < 2; ++n) acc[a][b][m][n] = (f32x4){0.f, 0.f, 0.f, 0.f};
        cur = nxt; cA = nA; cB = nB; ++ui;
        if constexpr (ALIGN_EPI) { if (wr == 1) PG8_BAR; }
    }
    PG8_WAIT_V(0);
    if constexpr (!ALIGN_EPI) { if (wr == 0) PG8_BAR; }
    PG8_BAR;
    if constexpr (Epi::AFTER_DRAIN) { E.fused(acc, cur, wr, wc, fr, fq, lds, wid, lane); S.done(cur); }
#undef PG8_SA
#undef PG8_SB
#undef PG8_STAGE
#undef PG8_LDA
#undef PG8_LDB
#undef PG8_MMA
#undef PG8_WAIT_V
#undef PG8_WAIT_L
#undef PG8_BAR
#undef PG8_SCHED
}
}

#define LAS __attribute__((address_space(3)))
typedef unsigned short bf16;
typedef unsigned v4u __attribute__((ext_vector_type(4)));
typedef unsigned v2u __attribute__((ext_vector_type(2)));
typedef float f32x4 __attribute__((ext_vector_type(4)));
typedef short bf16x8 __attribute__((ext_vector_type(8)));
typedef LAS unsigned char* ldsp;

constexpr int M = 16384, D = 2048, FF = 5632, NFF = 2 * FF, NIN = 3584, PW = 3072, SEQ = 4096;
constexpr float EPS = 1e-5f, LOG2E = 1.4426950408889634f;
constexpr int NTHREADS = 512, NWAVES = 8;
constexpr int LDS_BYTES = 147456;

constexpr size_t MiB = 1u << 20;
constexpr size_t WS_SS = 1 * MiB;
constexpr size_t WS_CS = 2 * MiB;
constexpr size_t WS_W = 4 * MiB;
constexpr size_t WL_F1I = 0, WL_F1O = 44 * MiB, WL_IN = 66 * MiB, WL_OUT = 80 * MiB, WL_F2I = 88 * MiB, WL_F2O = 132 * MiB, WL_SIZE = 154 * MiB;
constexpr size_t WS_XB = WS_W + 2 * WL_SIZE;
constexpr size_t WS_ACT = WS_XB + 64 * MiB;
constexpr size_t WS_P = WS_ACT, WS_MX = WS_ACT + 96 * MiB;
constexpr size_t WS_END = WS_ACT + 176 * MiB;

__device__ __forceinline__ float bflo(unsigned u) { return __uint_as_float(u << 16); }
__device__ __forceinline__ float bfhi(unsigned u) { return __uint_as_float(u & 0xffff0000u); }
__device__ __forceinline__ unsigned pk(float lo, float hi) { return pg8::cvt_pk_bf16(lo, hi); }
__device__ __forceinline__ float wave_sum(float v) {
    v += __builtin_bit_cast(float, __builtin_amdgcn_update_dpp(0, __builtin_bit_cast(int, v), 0x111, 0xf, 0xf, true));
    v += __builtin_bit_cast(float, __builtin_amdgcn_update_dpp(0, __builtin_bit_cast(int, v), 0x112, 0xf, 0xf, true));
    v += __builtin_bit_cast(float, __builtin_amdgcn_update_dpp(0, __builtin_bit_cast(int, v), 0x114, 0xf, 0xf, true));
    v += __builtin_bit_cast(float, __builtin_amdgcn_update_dpp(0, __builtin_bit_cast(int, v), 0x118, 0xf, 0xf, true));
    v += __builtin_bit_cast(float, __builtin_amdgcn_update_dpp(0, __builtin_bit_cast(int, v), 0x142, 0xa, 0xf, false));
    v += __builtin_bit_cast(float, __builtin_amdgcn_update_dpp(0, __builtin_bit_cast(int, v), 0x143, 0xc, 0xf, false));
    return __builtin_bit_cast(float, __builtin_amdgcn_readlane(__builtin_bit_cast(int, v), 63));
}
__device__ __forceinline__ float fast_sigmoid(float x) { return __builtin_amdgcn_rcpf(1.0f + __builtin_amdgcn_exp2f(-x * LOG2E)); }

struct EpiSwiGLU {
    static constexpr bool PERM = true, AFTER_DRAIN = false;
    bf16* O; const float* ss;
    __device__ __forceinline__ void operator()(const f32x4 (&acc)[2][2][4][2], const pg8::Unit& u, int wr, int wc, int fr, int fq) const {
        const int row0 = u.pm * 256 + wr * 64 + fr, col0 = u.pn * 128 + wc * 32 + 8 * fq;
        float rr[8];
#pragma unroll
        for (int k = 0; k < 8; ++k) rr[k] = ss[row0 + (k >> 2) * 128 + (k & 3) * 16];
#pragma unroll
        for (int k = 0; k < 8; ++k) rr[k] = __builtin_amdgcn_rsqf(rr[k] * (1.0f / D) + EPS);
#pragma unroll
        for (int ai = 0; ai < 2; ++ai)
#pragma unroll
            for (int m = 0; m < 4; ++m) {
                const int row = row0 + ai * 128 + m * 16;
                const float r = rr[ai * 4 + m];
                float o[8];
#pragma unroll
                for (int n = 0; n < 2; ++n)
#pragma unroll
                    for (int i = 0; i < 4; ++i) { const float g = acc[ai][0][m][n][i] * r, uu = acc[ai][1][m][n][i] * r; o[4 * n + i] = g * fast_sigmoid(g) * uu; }
                v4u w; w.x = pk(o[0], o[1]); w.y = pk(o[2], o[3]); w.z = pk(o[4], o[5]); w.w = pk(o[6], o[7]);
                *(v4u*)(O + (size_t)row * FF + col0) = w;
            }
    }
};
struct EpiResid {
    static constexpr bool PERM = true, AFTER_DRAIN = false;
    const float* base; float* out; bf16* xb; float* ss_out; float scale;
    __device__ __forceinline__ void operator()(const f32x4 (&acc)[2][2][4][2], const pg8::Unit& u, int wr, int wc, int fr, int fq) const {
        const int row0 = u.pm * 256 + wr * 64 + fr, col0 = u.pn * 256 + wc * 32 + 8 * fq;
#pragma unroll
        for (int ai = 0; ai < 2; ++ai)
#pragma unroll
            for (int m = 0; m < 4; ++m) {
                const int row = row0 + ai * 128 + m * 16; float sq = 0.f;
#pragma unroll
                for (int bj = 0; bj < 2; ++bj) {
                    const size_t off = (size_t)row * D + col0 + bj * 128;
                    const f32x4 b0 = *(const f32x4*)(base + off), b1 = *(const f32x4*)(base + off + 4);
                    const f32x4 x0 = b0 + acc[ai][bj][m][0] * scale, x1 = b1 + acc[ai][bj][m][1] * scale;
                    *(f32x4*)(out + off) = x0; *(f32x4*)(out + off + 4) = x1;
                    v4u w; w.x = pk(x0[0], x0[1]); w.y = pk(x0[2], x0[3]); w.z = pk(x1[0], x1[1]); w.w = pk(x1[2], x1[3]);
                    *(v4u*)(xb + off) = w;
                    sq += (x0[0] * x0[0] + x0[1] * x0[1]) + (x0[2] * x0[2] + x0[3] * x0[3]) + (x1[0] * x1[0] + x1[1] * x1[1]) + (x1[2] * x1[2] + x1[3] * x1[3]);
                }
                sq += __shfl_xor(sq, 16); sq += __shfl_xor(sq, 32);
                if (fq == 0) unsafeAtomicAdd(ss_out + row, sq);
                if (m & 1) asm volatile("" ::: "memory");
            }
    }
};
struct EpiMixIn {
    static constexpr bool PERM = true, AFTER_DRAIN = false;
    bf16* P; const float* ss; const float* cs;
    __device__ __forceinline__ void operator()(const f32x4 (&acc)[2][2][4][2], const pg8::Unit& u, int wr, int wc, int fr, int fq) const {
        const int row0 = u.pm * 256 + wr * 64 + fr, pn = u.pn, lc = wc * 32 + 8 * fq;
        float rr[8];
#pragma unroll
        for (int k = 0; k < 8; ++k) rr[k] = ss[row0 + (k >> 2) * 128 + (k & 3) * 16];
#pragma unroll
        for (int k = 0; k < 8; ++k) rr[k] = __builtin_amdgcn_rsqf(rr[k] * (1.0f / D) + EPS);
#pragma unroll
        for (int ai = 0; ai < 2; ++ai)
#pragma unroll
            for (int m = 0; m < 4; ++m) {
                const int row = row0 + ai * 128 + m * 16;
                const float r = rr[ai * 4 + m];
                f32x4 a0 = acc[ai][0][m][0] * r, a1 = acc[ai][0][m][1] * r, b0 = acc[ai][1][m][0] * r, b1 = acc[ai][1][m][1] * r;
                bf16* prow = P + (size_t)row * PW;
                if (pn >= 6 && pn < 10) {
                    float o[8];
#pragma unroll
                    for (int i = 0; i < 4; ++i) { o[i] = a0[i] * fast_sigmoid(b0[i]); o[4 + i] = a1[i] * fast_sigmoid(b1[i]); }
                    v4u w; w.x = pk(o[0], o[1]); w.y = pk(o[2], o[3]); w.z = pk(o[4], o[5]); w.w = pk(o[6], o[7]);
                    *(v4u*)(prow + 1536 + 128 * (pn - 6) + lc) = w;
                } else {
                    if (pn < 5) {
                        if ((wc & 1) == 0) {
                            f32x4 pa0, pa1, pb0, pb1;
#pragma unroll
                            for (int i = 0; i < 4; ++i) { pa0[i] = __shfl_xor(a0[i], 16); pa1[i] = __shfl_xor(a1[i], 16); pb0[i] = __shfl_xor(b0[i], 16); pb1[i] = __shfl_xor(b1[i], 16); }
                            if (fq < 2) {
                                const float* c = cs + (size_t)row * 16;
                                const f32x4 c0 = *(const f32x4*)c, c1 = *(const f32x4*)(c + 4); f32x4 s0 = *(const f32x4*)(c + 8), s1 = *(const f32x4*)(c + 12);
                                if (fq == 0) { s0 = -s0; s1 = -s1; }
                                a0 = a0 * c0 + pa0 * s0; a1 = a1 * c1 + pa1 * s1; b0 = b0 * c0 + pb0 * s0; b1 = b1 * c1 + pb1 * s1;
                            }
                        }
                        if (pn < 4) { a0 = a0 * 0.125f; a1 = a1 * 0.125f; b0 = b0 * 0.125f; b1 = b1 * 0.125f; }
                    }
                    const int cb = (pn <= 5 ? 256 * pn : 256 * pn - 512) + lc;
                    v4u w; w.x = pk(a0[0], a0[1]); w.y = pk(a0[2], a0[3]); w.z = pk(a1[0], a1[1]); w.w = pk(a1[2], a1[3]);
                    *(v4u*)(prow + cb) = w;
                    v4u z; z.x = pk(b0[0], b0[1]); z.y = pk(b0[2], b0[3]); z.z = pk(b1[0], b1[1]); z.w = pk(b1[2], b1[3]);
                    *(v4u*)(prow + cb + 128) = z;
                }
                if (m & 1) asm volatile("" ::: "memory");
            }
    }
};

__device__ __forceinline__ void transpose_item(const float* W, int K, int N, const float* g, bf16* WT, int k0, int n0, int sn0, LAS unsigned* scr, int lane) {
    const int c4 = lane & 31, ph = lane >> 5;
    const float* src = W + (size_t)(k0 + 2 * ph) * N + sn0 + 4 * c4;
    f32x4 ra[16], rb[16];
#pragma unroll
    for (int i = 0; i < 16; ++i) { ra[i] = *(const f32x4*)(src + (size_t)(4 * i) * N); rb[i] = *(const f32x4*)(src + (size_t)(4 * i + 1) * N); }
#pragma unroll
    for (int i = 0; i < 16; ++i) {
        const int p = ph + 2 * i;
        float ga = 1.f, gb = 1.f; if (g) { ga = g[k0 + 2 * p]; gb = g[k0 + 2 * p + 1]; }
        LAS unsigned* d = scr + p * 129 + c4;
        d[0] = pk(ra[i][0] * ga, rb[i][0] * gb); d[32] = pk(ra[i][1] * ga, rb[i][1] * gb); d[64] = pk(ra[i][2] * ga, rb[i][2] * gb); d[96] = pk(ra[i][3] * ga, rb[i][3] * gb);
    }
    asm volatile("s_waitcnt lgkmcnt(0)" ::: "memory");
    const int c = lane & 7, q = lane >> 3;
#pragma unroll
    for (int j = 0; j < 16; ++j) {
        const int n = 4 * ((q & 3) + 4 * (j >> 1)) + ((q >> 2) + 2 * (j & 1));
        const LAS unsigned* sp = scr + (4 * c) * 129 + (n & 3) * 32 + (n >> 2);
        v4u o; o.x = sp[0]; o.y = sp[129]; o.z = sp[258]; o.w = sp[387];
        *(v4u*)(WT + (size_t)(n0 + n) * K + k0 + 8 * c) = o;
    }
    asm volatile("s_waitcnt lgkmcnt(0)" ::: "memory");
}
__device__ __forceinline__ int src_col(int mode, int n0) {
    if (mode == 1) return ((n0 >> 7) & 1) * FF + 128 * (n0 >> 8) + (n0 & 127);
    if (mode == 2) { const int pn = n0 >> 8; if (pn >= 6 && pn < 10) return 1536 + 512 * ((n0 >> 7) & 1) + 128 * (pn - 6) + (n0 & 127); }
    return n0;
}
__device__ __forceinline__ void convert_matrix(const float* W, int K, int N, const float* g, bf16* WT, int mode, int item, LAS unsigned* scr, int lane) {
    const int nblk = N / 128, kb = item / nblk, nb = item % nblk;
    transpose_item(W, K, N, g, WT, 64 * kb, 128 * nb, src_col(mode, 128 * nb), scr, lane);
}

struct Args {
    const float* x; const int* pos;
    const float *norm_ffn1, *ffn1_w_in, *ffn1_w_out, *norm_mix, *w_in, *conv_dw_w, *conv_dw_b, *conv_ln_g, *conv_ln_b, *sgu_ln_g, *sgu_ln_b, *sgu_w, *sgu_b, *attn_sinks, *w_out,
        *norm_ffn2, *ffn2_w_in, *ffn2_w_out, *final_norm;
    float* out; unsigned char* ws;
};

__device__ __forceinline__ void prologue(const Args& a, ldsp lds, int gw, int NGW, int lane, int wave) {
    LAS unsigned* scr = (LAS unsigned*)(lds + wave * 16640);
    constexpr int I_FI = (D / 64) * (NFF / 128), I_FO = (FF / 64) * (D / 128), I_IN = (D / 64) * (NIN / 128), I_OUT = (D / 64) * (D / 128);
    constexpr int I_LAYER = 2 * I_FI + 2 * I_FO + I_IN + I_OUT;
    for (int it = gw; it < 2 * I_LAYER; it += NGW) {
        const int l = it / I_LAYER; int r = it % I_LAYER;
        unsigned char* wl = a.ws + WS_W + (size_t)l * WL_SIZE;
        if (r < I_FI) { convert_matrix(a.ffn1_w_in + (size_t)l * D * NFF, D, NFF, a.norm_ffn1 + l * D, (bf16*)(wl + WL_F1I), 1, r, scr, lane); continue; } r -= I_FI;
        if (r < I_FI) { convert_matrix(a.ffn2_w_in + (size_t)l * D * NFF, D, NFF, a.norm_ffn2 + l * D, (bf16*)(wl + WL_F2I), 1, r, scr, lane); continue; } r -= I_FI;
        if (r < I_IN) { convert_matrix(a.w_in + (size_t)l * D * NIN, D, NIN, a.norm_mix + l * D, (bf16*)(wl + WL_IN), 2, r, scr, lane); continue; } r -= I_IN;
        if (r < I_FO) { convert_matrix(a.ffn1_w_out + (size_t)l * FF * D, FF, D, nullptr, (bf16*)(wl + WL_F1O), 0, r, scr, lane); continue; } r -= I_FO;
        if (r < I_FO) { convert_matrix(a.ffn2_w_out + (size_t)l * FF * D, FF, D, nullptr, (bf16*)(wl + WL_F2O), 0, r, scr, lane); continue; } r -= I_FO;
        convert_matrix(a.w_out + (size_t)l * D * D, D, D, nullptr, (bf16*)(wl + WL_OUT), 0, r, scr, lane);
    }
}

__device__ __forceinline__ void prologue_rows(const Args& a, int gw, int NGW, int lane, int gtid, int NGT) {
    bf16* XB = (bf16*)(a.ws + WS_XB); float* ss0 = (float*)(a.ws + WS_SS);
    for (int m = gw; m < M; m += NGW) {
        const f32x4* xr = (const f32x4*)(a.x + (size_t)m * D) + lane; v2u* o8 = (v2u*)(XB + (size_t)m * D) + lane; float s = 0.f;
#pragma unroll
        for (int j = 0; j < 8; ++j) { const f32x4 v = xr[64 * j]; s += (v[0] * v[0] + v[1] * v[1]) + (v[2] * v[2] + v[3] * v[3]); v2u w; w.x = pk(v[0], v[1]); w.y = pk(v[2], v[3]); o8[64 * j] = w; }
        s = wave_sum(s);
        if (lane == 0) ss0[m] = s;
    }
    for (int i = gtid; i < 6 * M; i += NGT) ss0[M + i] = 0.f;
    float* cs = (float*)(a.ws + WS_CS);
    for (int i = gtid; i < M * 8; i += NGT) {
        const int m = i >> 3, f = i & 7;
        const float invf[8] = {1.0f, 0.193922758102417f, 0.03760603070259094f, 0.00729266507551074f, 0.001414213445968926f, 0.00027424818836152554f, 5.318296462064609e-05f, 1.0313385246263351e-05f};
        float fr_ = invf[0];
#pragma unroll
        for (int k = 1; k < 8; ++k) fr_ = (f == k) ? invf[k] : fr_;
        const float ang = (float)a.pos[m] * fr_;
        double t = (double)ang * 0.15915494309189533577; t -= __builtin_rint(t);
        const float tf = (float)t;
        cs[(size_t)m * 16 + f] = __builtin_amdgcn_cosf(tf); cs[(size_t)m * 16 + 8 + f] = __builtin_amdgcn_sinf(tf);
    }
}

#define MFMA16(a, b, c) __builtin_amdgcn_mfma_f32_16x16x32_bf16(a, b, c, 0, 0, 0)

__device__ __forceinline__ void attn_unit(ldsp lds, const bf16* P, bf16* MX, const float* sinks, int b, int n, int g, int tid) {
    const int lane = tid & 63, wid = tid >> 6, fr = lane & 15, fq = lane >> 4;
    ldsp Kl = lds; ldsp Vl = lds + 36864;
    const int tok0 = b * SEQ + n * 128;
    const int hq = 4 * g + (wid >> 1), half = wid & 1;
    v4u kvr[4], vvr[4];
#pragma unroll
    for (int i = 0; i < 4; ++i) {
        const int p = tid + 512 * i, key = p >> 3, ch = p & 7;
        kvr[i] = (v4u){0u, 0u, 0u, 0u}; vvr[i] = (v4u){0u, 0u, 0u, 0u};
        if (n > 0 || key >= 128) { const bf16* src = P + (size_t)(tok0 - 128 + key) * PW + 64 * g + 8 * ch; kvr[i] = *(const v4u*)(src + 1024); vvr[i] = *(const v4u*)(src + 1280); }
    }
    const bf16* qbase = P + (size_t)(tok0 + 64 * half + fr) * PW + 64 * hq + 8 * fq;
    bf16x8 qn0 = *(const bf16x8*)qbase, qn1 = *(const bf16x8*)(qbase + 32);
    const float sink = sinks[hq];
#pragma unroll
    for (int i = 0; i < 4; ++i) {
        const int p = tid + 512 * i, key = p >> 3, ch = p & 7;
        *(LAS v4u*)(Kl + key * 144 + ch * 16) = kvr[i];
#pragma unroll
        for (int j = 0; j < 8; ++j) { const unsigned e = (vvr[i][j >> 1] >> (16 * (j & 1))) & 0xffffu; *(LAS unsigned short*)(Vl + (8 * ch + j) * 528 + key * 2) = (unsigned short)e; }
    }
    __syncthreads();
#pragma unroll 1
    for (int mt = 0; mt < 4; ++mt) {
        const int mp = 4 * half + mt;
        const bf16x8 q0 = qn0, q1 = qn1;
        { const bf16* qnx = qbase + (size_t)(16 * (mt < 3 ? mt + 1 : 3)) * PW; qn0 = *(const bf16x8*)qnx; qn1 = *(const bf16x8*)(qnx + 32); }
        f32x4 s[9];
#pragma unroll
        for (int kt = 0; kt < 9; ++kt) {
            ldsp kp = Kl + (16 * (mp + kt) + fr) * 144 + fq * 16;
            const bf16x8 k0 = *(const LAS bf16x8*)kp, k1 = *(const LAS bf16x8*)(kp + 64);
            f32x4 z = {0.f, 0.f, 0.f, 0.f};
            z = MFMA16(k0, q0, z); z = MFMA16(k1, q1, z); s[kt] = z;
        }
#pragma unroll
        for (int i = 0; i < 4; ++i) { if (!(4 * fq + i > fr)) s[0][i] = -1e30f; if (!(4 * fq + i <= fr)) s[8][i] = -1e30f; }
        if (n == 0) {
#pragma unroll
            for (int kt = 0; kt < 8; ++kt) if (mp + kt < 8) s[kt] = (f32x4){-1e30f, -1e30f, -1e30f, -1e30f};
        }
        float mx = sink;
#pragma unroll
        for (int kt = 0; kt < 9; ++kt) mx = fmaxf(mx, fmaxf(fmaxf(s[kt][0], s[kt][1]), fmaxf(s[kt][2], s[kt][3])));
        mx = fmaxf(mx, __shfl_xor(mx, 16)); mx = fmaxf(mx, __shfl_xor(mx, 32));
        float sum = 0.f; const float mxl = mx * LOG2E;
#pragma unroll
        for (int kt = 0; kt < 9; ++kt)
#pragma unroll
            for (int i = 0; i < 4; ++i) { const float p = __builtin_amdgcn_exp2f(s[kt][i] * LOG2E - mxl); s[kt][i] = p; sum += p; }
        sum += __shfl_xor(sum, 16); sum += __shfl_xor(sum, 32);
        sum += __builtin_amdgcn_exp2f(sink * LOG2E - mxl);
        const float inv = 1.0f / sum;
        f32x4 o[4];
#pragma unroll
        for (int nd = 0; nd < 4; ++nd) o[nd] = (f32x4){0.f, 0.f, 0.f, 0.f};
#pragma unroll
        for (int sp = 0; sp < 5; ++sp) {
            const int tA = mp + 2 * sp, tB = (sp < 4) ? tA + 1 : tA;
            v4u pw; pw.x = pk(s[2 * sp][0], s[2 * sp][1]); pw.y = pk(s[2 * sp][2], s[2 * sp][3]);
            const int iB = (sp < 4) ? 2 * sp + 1 : 8;
            if (sp < 4) { pw.z = pk(s[iB][0], s[iB][1]); pw.w = pk(s[iB][2], s[iB][3]); } else { pw.z = 0u; pw.w = 0u; }
            const bf16x8 pf = __builtin_bit_cast(bf16x8, pw);
#pragma unroll
            for (int nd = 0; nd < 4; ++nd) {
                ldsp vr = Vl + (16 * nd + fr) * 528 + 8 * fq;
                v4u vw; const v2u va = *(const LAS v2u*)(vr + 32 * tA), vb = *(const LAS v2u*)(vr + 32 * tB);
                vw.x = va.x; vw.y = va.y; vw.z = vb.x; vw.w = vb.y;
                o[nd] = MFMA16(__builtin_bit_cast(bf16x8, vw), pf, o[nd]);
            }
        }
        bf16* orow = MX + (size_t)(tok0 + 16 * mp + fr) * D + 64 * hq + 4 * fq;
#pragma unroll
        for (int nd = 0; nd < 4; ++nd) { v2u w; w.x = pk(o[nd][0] * inv, o[nd][1] * inv); w.y = pk(o[nd][2] * inv, o[nd][3] * inv); *(v2u*)(orow + 16 * nd) = w; }
    }
    __syncthreads();
}

typedef float f32x2 __attribute__((ext_vector_type(2)));
__device__ __forceinline__ void conv_unit(ldsp lds, const bf16* P, bf16* MX, const float* dw_w, const float* dw_b, const float* ln_g, const float* ln_b, int cu, int tid) {
    const int lane = tid & 63, wid = tid >> 6;
    const int tok0 = 32 * cu, s0 = tok0 & (SEQ - 1);
    ldsp Wl = lds + 65536;
    v4u st[8]; f32x4 sw[8];
#pragma unroll
    for (int i = 0; i < 8; ++i) {
        const int p = tid + NTHREADS * i, r = p >> 6, c = p & 63; st[i] = (v4u){0u, 0u, 0u, 0u};
        if (p < 3968 && s0 - 30 + r >= 0) st[i] = *(const v4u*)(P + (size_t)(tok0 - 30 + r) * PW + 1536 + 8 * c);
        sw[i] = (f32x4){0.f, 0.f, 0.f, 0.f};
        if (p < 3968) sw[i] = *(const f32x4*)(dw_w + 4 * p);
    }
#pragma unroll
    for (int i = 0; i < 8; ++i) {
        const int p = tid + NTHREADS * i, r = p >> 6, c = p & 63;
        if (p < 3968) { *(LAS v4u*)(lds + r * 1040 + c * 16) = st[i]; *(LAS f32x4*)(Wl + p * 16) = sw[i]; }
    }
    __syncthreads();
    const int c0 = 8 * lane;
    f32x2 acc[4][4];
#pragma unroll
    for (int t = 0; t < 4; ++t)
#pragma unroll
        for (int k = 0; k < 4; ++k) acc[t][k] = (f32x2){0.f, 0.f};
    ldsp rb = lds + (4 * wid) * 1040 + lane * 16; ldsp wb = Wl + lane * 32;
#pragma unroll 1
    for (int j = 0; j < 31; ++j) {
        const f32x4 w0 = *(const LAS f32x4*)(wb + j * 2048), w1 = *(const LAS f32x4*)(wb + j * 2048 + 16);
        const f32x2 wv[4] = {{w0[0], w0[1]}, {w0[2], w0[3]}, {w1[0], w1[1]}, {w1[2], w1[3]}};
#pragma unroll
        for (int t = 0; t < 4; ++t) {
            const v4u hv = *(const LAS v4u*)(rb + (t + j) * 1040);
#pragma unroll
            for (int k = 0; k < 4; ++k) { const f32x2 h2 = {bflo(hv[k]), bfhi(hv[k])}; acc[t][k] += h2 * wv[k]; }
        }
    }
    const f32x4 bb0 = *(const f32x4*)(dw_b + c0), bb1 = *(const f32x4*)(dw_b + c0 + 4), g0 = *(const f32x4*)(ln_g + c0), g1 = *(const f32x4*)(ln_g + c0 + 4), e0 = *(const f32x4*)(ln_b + c0), e1 = *(const f32x4*)(ln_b + c0 + 4);
#pragma unroll
    for (int t = 0; t < 4; ++t) {
        f32x4 y0 = (f32x4){acc[t][0][0], acc[t][0][1], acc[t][1][0], acc[t][1][1]} + bb0, y1 = (f32x4){acc[t][2][0], acc[t][2][1], acc[t][3][0], acc[t][3][1]} + bb1;
        const float s = (y0[0] + y0[1]) + (y0[2] + y0[3]) + (y1[0] + y1[1]) + (y1[2] + y1[3]);
        const float mean = wave_sum(s) * (1.0f / 512.0f);
        y0 = y0 - mean; y1 = y1 - mean;
        const float q = (y0[0] * y0[0] + y0[1] * y0[1]) + (y0[2] * y0[2] + y0[3] * y0[3]) + (y1[0] * y1[0] + y1[1] * y1[1]) + (y1[2] * y1[2] + y1[3] * y1[3]);
        const float rstd = __builtin_amdgcn_rsqf(wave_sum(q) * (1.0f / 512.0f) + EPS);
        y0 = y0 * rstd * g0 + e0; y1 = y1 * rstd * g1 + e1;
#pragma unroll
        for (int c = 0; c < 4; ++c) { y0[c] = y0[c] * fast_sigmoid(y0[c]); y1[c] = y1[c] * fast_sigmoid(y1[c]); }
        v4u w; w.x = pk(y0[0], y0[1]); w.y = pk(y0[2], y0[3]); w.z = pk(y1[0], y1[1]); w.w = pk(y1[2], y1[3]);
        *(v4u*)(MX + (size_t)(tok0 + 4 * wid + t) * D + 1024 + c0) = w;
    }
    __syncthreads();
}

__device__ __forceinline__ void sgu_unit(ldsp lds, const bf16* P, bf16* MX, const float* ln_g, const float* ln_b, const float* w_s, const float* b_s, int ck, int hf, int tid) {
    const int lane = tid & 63, wid = tid >> 6, fr = lane & 15, fq = lane >> 4;
    const int tok0 = 128 * ck, c0 = 8 * lane;
    const int hl = wid >> 1, hh = 4 * hf + hl, th = wid & 1;
    {
        const f32x4 g0 = *(const f32x4*)(ln_g + c0), g1 = *(const f32x4*)(ln_g + c0 + 4), e0 = *(const f32x4*)(ln_b + c0), e1 = *(const f32x4*)(ln_b + c0 + 4);
#pragma unroll 1
        for (int i4 = 0; i4 < 16; i4 += 4) {
        v4u raw4[4];
#pragma unroll
        for (int i = 0; i < 4; ++i) raw4[i] = *(const v4u*)(P + (size_t)(tok0 + 16 * wid + i4 + i) * PW + 2560 + c0);
#pragma unroll
        for (int i = 0; i < 4; ++i) {
            const int sidx = 16 * wid + i4 + i; const v4u rw = raw4[i];
            float v[8] = {bflo(rw.x), bfhi(rw.x), bflo(rw.y), bfhi(rw.y), bflo(rw.z), bfhi(rw.z), bflo(rw.w), bfhi(rw.w)};
            float s = 0.f;
#pragma unroll
            for (int c = 0; c < 8; ++c) s += v[c];
            const float mean = wave_sum(s) * (1.0f / 512.0f); float q = 0.f;
#pragma unroll
            for (int c = 0; c < 8; ++c) { v[c] -= mean; q += v[c] * v[c]; }
            const float rstd = __builtin_amdgcn_rsqf(wave_sum(q) * (1.0f / 512.0f) + EPS);
            if ((lane >> 5) == hf) {
#pragma unroll
                for (int c = 0; c < 8; ++c) { const float vn = v[c] * rstd * (c < 4 ? g0[c & 3] : g1[c & 3]) + (c < 4 ? e0[c & 3] : e1[c & 3]);
                    *(LAS unsigned short*)(lds + ((c0 & 255) + c) * 272 + 2 * sidx) = (unsigned short)(pk(vn, 0.f) & 0xffffu); }
            }
        }
        }
    }
    __syncthreads();
#pragma unroll 1
    for (int m = 0; m < 4; ++m) {
        const int t0 = 64 * th + 16 * m, t = t0 + fr;
        f32x4 acc[4];
#pragma unroll
        for (int nd = 0; nd < 4; ++nd) acc[nd] = (f32x4){0.f, 0.f, 0.f, 0.f};
        const float* wrow = w_s + ((size_t)hh * 128 + t) * 128;
        const int nks = (t0 + 15) / 32 + 1;
        f32x4 wa[4], wb[4];
#pragma unroll
        for (int ks = 0; ks < 4; ++ks) { const int kk = ks < nks ? ks : 0; wa[ks] = *(const f32x4*)(wrow + 32 * kk + 8 * fq); wb[ks] = *(const f32x4*)(wrow + 32 * kk + 8 * fq + 4); }
        const float bias = b_s[hh * 128 + t];
        v2u uu[4];
#pragma unroll
        for (int nd = 0; nd < 4; ++nd) uu[nd] = *(const v2u*)(P + (size_t)(tok0 + t) * PW + 2048 + 64 * hh + 16 * nd + 4 * fq);
#pragma unroll
        for (int ks = 0; ks < 4; ++ks) {
            if (ks < nks) {
                const int sb = 32 * ks + 8 * fq;
                f32x4 xa = wa[ks], xb = wb[ks];
#pragma unroll
                for (int i = 0; i < 4; ++i) { xa[i] = (sb + i <= t) ? xa[i] : 0.f; xb[i] = (sb + 4 + i <= t) ? xb[i] : 0.f; }
                v4u ww; ww.x = pk(xa[0], xa[1]); ww.y = pk(xa[2], xa[3]); ww.z = pk(xb[0], xb[1]); ww.w = pk(xb[2], xb[3]);
                const bf16x8 wf = __builtin_bit_cast(bf16x8, ww);
#pragma unroll
                for (int nd = 0; nd < 4; ++nd) {
                    const bf16x8 vf = *(const LAS bf16x8*)(lds + (64 * hl + 16 * nd + fr) * 272 + 64 * ks + 16 * fq);
                    acc[nd] = MFMA16(vf, wf, acc[nd]);
                }
            }
        }
#pragma unroll
        for (int nd = 0; nd < 4; ++nd) {
            const int ch = 64 * hh + 16 * nd + 4 * fq;
            v2u w; w.x = pk((acc[nd][0] + bias) * bflo(uu[nd].x), (acc[nd][1] + bias) * bfhi(uu[nd].x)); w.y = pk((acc[nd][2] + bias) * bflo(uu[nd].y), (acc[nd][3] + bias) * bfhi(uu[nd].y));
            *(v2u*)(MX + (size_t)(tok0 + t) * D + 1536 + ch) = w;
        }
    }
    __syncthreads();
}

#define XB_TMO      128
#define XB_XCNT(j)  (256  + 64 * (j))
#define XB_XSUB(j)  (1280 + 64 * (j))
#define XB_XGEN(j)  (2304 + 64 * (j))
#define XB_TOP      3328
#define XB_TOPGEN   3392
#define XCD_BAR_WORDS 3456
#define XB_SPIN_CAP (1u << 23)

__device__ __forceinline__ unsigned xb_ld(unsigned* p)              { return __hip_atomic_load(p, __ATOMIC_RELAXED, __HIP_MEMORY_SCOPE_AGENT); }
__device__ __forceinline__ unsigned xb_add(unsigned* p, unsigned v) { return __hip_atomic_fetch_add(p, v, __ATOMIC_RELAXED, __HIP_MEMORY_SCOPE_AGENT); }
__device__ __forceinline__ unsigned xb_xcc_id() { return (unsigned)__builtin_amdgcn_s_getreg((3 << 11) | 20) & 0xFu; }
#define XB_SPIN(cond, bar) do { unsigned _sp = 0; while (cond) { __builtin_amdgcn_s_sleep(1); \
    if ((++_sp & 255u) == 0u) { if (xb_ld(&(bar)[XB_TMO])) break; if (_sp > XB_SPIN_CAP) { atomicAdd(&(bar)[XB_TMO], 1u); break; } } } } while (0)

struct XcdBarrier {
    unsigned* bar; unsigned x;
    volatile LAS unsigned* st;
};

__device__ __forceinline__ XcdBarrier xcd_barrier_post(unsigned* bar, volatile LAS unsigned* st) {
    XcdBarrier b; b.bar = bar; b.x = xb_xcc_id(); b.st = st;
    if (threadIdx.x == 0) (void)xb_add(&bar[XB_XCNT(b.x)], 1u);
    return b;
}
__device__ __forceinline__ void xcd_barrier_complete(unsigned* bar, unsigned x, unsigned& nloc, unsigned& nx) {
    const unsigned G = gridDim.x * gridDim.y * gridDim.z;
    unsigned sum, cnt, mine, sp = 0u;
    for (;;) {
        sum = 0u; cnt = 0u; mine = 0u;
#pragma unroll
        for (unsigned j = 0; j < 16; ++j) { const unsigned c = xb_ld(&bar[XB_XCNT(j)]); sum += c; cnt += (c > 0u) ? 1u : 0u; mine = (j == x) ? c : mine; }
        if (sum == G) break;
        __builtin_amdgcn_s_sleep(1);
        if ((++sp & 255u) == 0u) { if (xb_ld(&bar[XB_TMO])) break; if (sp > XB_SPIN_CAP) { atomicAdd(&bar[XB_TMO], 1u); break; } }
    }
    nloc = mine > 0u ? mine : 1u; nx = cnt > 0u ? cnt : 1u;
}

__device__ __forceinline__ void xcd_barrier(const XcdBarrier& b) {
    asm volatile("s_waitcnt vmcnt(0)" ::: "memory");
    __syncthreads();
    if (threadIdx.x == 0) {
        unsigned* bar = b.bar;
        __builtin_amdgcn_s_waitcnt(0);
        unsigned nloc = b.st[0], nx = b.st[1];
        if (nloc == 0u) { xcd_barrier_complete(bar, b.x, nloc, nx); b.st[0] = nloc; b.st[1] = nx; }
        const unsigned old = xb_add(&bar[XB_XSUB(b.x)], 1u);
        const unsigned gen = old / nloc;
        if (old + 1u == (gen + 1u) * nloc) {
            __builtin_amdgcn_fence(__ATOMIC_RELEASE, "agent");
            asm volatile("s_waitcnt vmcnt(0)" ::: "memory");
            const unsigned og = xb_add(&bar[XB_TOP], 1u);
            const unsigned tg = og / nx;
            if (og + 1u == (tg + 1u) * nx) xb_add(&bar[XB_TOPGEN], 1u);
            else XB_SPIN(xb_ld(&bar[XB_TOPGEN]) == tg, bar);
            __builtin_amdgcn_fence(__ATOMIC_ACQUIRE, "agent");
            xb_add(&bar[XB_XGEN(b.x)], 1u);
            asm volatile("s_waitcnt vmcnt(0)" ::: "memory");
        } else {
            XB_SPIN(xb_ld(&bar[XB_XGEN(b.x)]) == gen, bar);
            __builtin_amdgcn_fence(__ATOMIC_ACQUIRE, "agent");
            asm volatile("s_waitcnt vmcnt(0)" ::: "memory");
        }
    }
    __syncthreads();
}

typedef const __attribute__((address_space(4))) Args* kargp;
__device__ __forceinline__ kargp kargs() { kargp p = (kargp)__builtin_amdgcn_kernarg_segment_ptr(); asm volatile("" : "+s"(p)); return p; }
__global__ void __launch_bounds__(NTHREADS, 2) fwd_megakernel(Args a_unused) {
    extern __shared__ __attribute__((aligned(16))) unsigned char lds_raw[];
    cg::grid_group grid = cg::this_grid();
    ldsp lds = (ldsp)lds_raw;
    const int tid = threadIdx.x, lane = tid & 63, wave = __builtin_amdgcn_readfirstlane(tid >> 6);
    const int G = gridDim.x, bid = blockIdx.x;
    const int gw = bid * NWAVES + wave, NGW = G * NWAVES, gtid = bid * NTHREADS + tid, NGT = G * NTHREADS;
    unsigned char* ws = kargs()->ws;

#ifndef PROBE_PRO
#define PROBE_PRO 1
#endif
#ifndef PROBE_MIX
#define PROBE_MIX 1
#endif
#ifndef PROBE_FFI
#define PROBE_FFI 1
#endif
    volatile LAS unsigned* bar_st = (volatile LAS unsigned*)(lds + LDS_BYTES - 64);
    if (tid < 2) bar_st[tid] = 0u;
    if (bid == 0) { unsigned* bw = (unsigned*)a_unused.ws; for (int i = tid; i < XCD_BAR_WORDS; i += NTHREADS) bw[i] = 0u; }
    for (int rep = 0; rep < PROBE_PRO; ++rep) prologue(a_unused, lds, gw, NGW, lane, wave);
    prologue_rows(a_unused, gw, NGW, lane, gtid, NGT);
    grid.sync();
    const XcdBarrier xbar = xcd_barrier_post((unsigned*)ws, bar_st);

    for (int step = 0; step < 6; ++step) {
        const int l = step / 3, sub = step % 3;
        ws = kargs()->ws; const unsigned char* wl = ws + WS_W + (size_t)l * WL_SIZE;
        float* ssb = (float*)(ws + WS_SS); const float* cs = (const float*)(ws + WS_CS);
        bf16* XB = (bf16*)(ws + WS_XB); bf16* ACT = (bf16*)(ws + WS_ACT); bf16* PB = (bf16*)(ws + WS_P); bf16* MX = (bf16*)(ws + WS_MX);
        const float* ss_in = ssb + (size_t)step * M; float* ss_out = ssb + (size_t)(step + 1) * M;
        const bf16* A2; const bf16* B2; int K2; float scale;
        if (sub != 1) {
            pg8::Gemm g{XB, (const bf16*)(wl + (sub == 0 ? WL_F1I : WL_F2I)), M, NFF, D}; pg8::StaticOrder S; S.init(M, NFF, G, bid);
            EpiSwiGLU E{ACT, ss_in};
            for (int rep = 0; rep < PROBE_FFI; ++rep) pg8::gemm_phase<EpiSwiGLU, pg8::StaticOrder, true, true>(lds, g, S, E);
            xcd_barrier(xbar);
            A2 = ACT; B2 = (const bf16*)(wl + (sub == 0 ? WL_F1O : WL_F2O)); K2 = FF; scale = 0.5f;
        } else {
            {
                pg8::Gemm g{XB, (const bf16*)(wl + WL_IN), M, NIN, D}; pg8::StaticOrder S; S.init(M, NIN, G, bid);
                EpiMixIn E{PB, ss_in, cs};
                pg8::gemm_phase<EpiMixIn, pg8::StaticOrder, true, true>(lds, g, S, E);
            }
            xcd_barrier(xbar);
            for (int rep = 0; rep < PROBE_MIX; ++rep)
            for (int u = bid; u < 1280; u += G) {
                kargp a = kargs(); int tl = threadIdx.x; asm volatile("" : "+v"(tl));
                if (u < 512) attn_unit(lds, PB, MX, a->attn_sinks + l * 16, u >> 7, (u & 127) >> 2, u & 3, tl);
                else if (u < 1024) conv_unit(lds, PB, MX, a->conv_dw_w + (size_t)l * 31 * 512, a->conv_dw_b + l * 512, a->conv_ln_g + l * 512, a->conv_ln_b + l * 512, u - 512, tl);
                else sgu_unit(lds, PB, MX, a->sgu_ln_g + l * 512, a->sgu_ln_b + l * 512, a->sgu_w + (size_t)l * 8 * 128 * 128, a->sgu_b + l * 8 * 128, (u - 1024) >> 1, (u - 1024) & 1, tl);
            }
            xcd_barrier(xbar);
            A2 = MX; B2 = (const bf16*)(wl + WL_OUT); K2 = D; scale = 1.0f;
        }
        {
            pg8::Gemm g{A2, B2, M, D, K2}; pg8::StaticOrder S; S.init(M, D, G, bid);
            kargp a = kargs(); float* outp = a->out;
            EpiResid E{step == 0 ? a->x : (const float*)outp, outp, XB, ss_out, scale};
            pg8::gemm_phase<EpiResid, pg8::StaticOrder, true, true>(lds, g, S, E);
        }
        xcd_barrier(xbar);
    }
    {
        kargp a = kargs(); const float* ss = (const float*)(a->ws + WS_SS) + (size_t)6 * M; float* outp = a->out; const float* fng = a->final_norm;
        for (int m = gw; m < M; m += NGW) {
            const float r = rsqrtf(ss[m] * (1.0f / D) + EPS);
            f32x4* xr = (f32x4*)(outp + (size_t)m * D) + lane; const f32x4* gr = (const f32x4*)fng + lane;
#pragma unroll
            for (int j = 0; j < 8; ++j) { const f32x4 v = xr[64 * j], gg = gr[64 * j]; xr[64 * j] = v * r * gg; }
        }
    }
}

extern "C" void kernel_launch(void* const* d_in, const int* in_sizes, int n_in, void* d_out, int out_size, void* d_ws, size_t ws_size, hipStream_t stream) {
    static int grid_blocks = 0;
    if (grid_blocks == 0) {
        if (n_in != 21 || out_size != M * D || ws_size < WS_END) { fprintf(stderr, "kernel_launch: unexpected shapes (n_in %d out %d ws %zu need %zu)\n", n_in, out_size, ws_size, (size_t)WS_END); grid_blocks = -1; return; }
        int dev = 0, cus = 0, per_cu = 0;
        (void)hipGetDevice(&dev);
        (void)hipDeviceGetAttribute(&cus, hipDeviceAttributeMultiprocessorCount, dev);
        if (hipFuncSetAttribute((const void*)fwd_megakernel, hipFuncAttributeMaxDynamicSharedMemorySize, LDS_BYTES) != hipSuccess) { fprintf(stderr, "kernel_launch: hipFuncSetAttribute failed\n"); grid_blocks = -1; return; }
        if (hipOccupancyMaxActiveBlocksPerMultiprocessor(&per_cu, (const void*)fwd_megakernel, NTHREADS, LDS_BYTES) != hipSuccess || per_cu < 1) { fprintf(stderr, "kernel_launch: occupancy query says %d\n", per_cu); per_cu = 1; (void)hipGetLastError(); }
        grid_blocks = cus * per_cu;
    }
    if (grid_blocks < 0) return;
    Args a{};
    a.x = (const float*)d_in[0]; a.pos = (const int*)d_in[1];
    a.norm_ffn1 = (const float*)d_in[2]; a.ffn1_w_in = (const float*)d_in[3]; a.ffn1_w_out = (const float*)d_in[4]; a.norm_mix = (const float*)d_in[5]; a.w_in = (const float*)d_in[6];
    a.conv_dw_w = (const float*)d_in[7]; a.conv_dw_b = (const float*)d_in[8]; a.conv_ln_g = (const float*)d_in[9]; a.conv_ln_b = (const float*)d_in[10];
    a.sgu_ln_g = (const float*)d_in[11]; a.sgu_ln_b = (const float*)d_in[12]; a.sgu_w = (const float*)d_in[13]; a.sgu_b = (const float*)d_in[14]; a.attn_sinks = (const float*)d_in[15];
    a.w_out = (const float*)d_in[16]; a.norm_ffn2 = (const float*)d_in[17]; a.ffn2_w_in = (const float*)d_in[18]; a.ffn2_w_out = (const float*)d_in[19]; a.final_norm = (const float*)d_in[20];
    a.out = (float*)d_out; a.ws = (unsigned char*)d_ws;
    void* args[] = {&a};
    hipError_t e = hipLaunchCooperativeKernel((const void*)fwd_megakernel, dim3(grid_blocks), dim3(NTHREADS), args, LDS_BYTES, stream);
    if (e != hipSuccess) fprintf(stderr, "kernel_launch: cooperative launch failed: %s (grid %d)\n", hipGetErrorString(e), grid_blocks);
}
```

```cpp
#include <hip/hip_runtime.h>
#include <hip/hip_cooperative_groups.h>
#include <cstdio>
#include <cstdint>
namespace cg = cooperative_groups;
namespace pg8 {
#define PG8_LAS __attribute__((address_space(3)))
typedef unsigned short bf16_t;
typedef short bf16x8 __attribute__((ext_vector_type(8)));
typedef float f32x4 __attribute__((ext_vector_type(4)));
typedef unsigned u32x4 __attribute__((ext_vector_type(4)));
constexpr int BM = 256, BK = 64, HALF = 128, HTB = HALF * BK * 2  , STAGE_BYTES = 8 * HTB, NXCD = 8, WGM = 8;

__host__ __device__ __forceinline__ int lds_byte(int r, int c) { const int st = (r >> 4) * 2 + (c >> 5), rr = r & 15, cc = c & 31, ob = rr * 64 + cc * 2; return st * 1024 + (ob ^ (((ob >> 9) & 1) << 5)); }
__host__ __device__ __forceinline__ void stage_rc(int b, int& R, int& C) { const int st = b / 1024, sb = b % 1024, swz = sb ^ (((sb >> 9) & 1) << 5); R = (st >> 1) * 16 + swz / 64; C = (st & 1) * 32 + (swz % 64) / 2; }
__host__ __device__ __forceinline__ int perm32(int rho) { const int n = rho >> 4, i = rho & 15; return 8 * (i >> 2) + 4 * n + (i & 3); }

struct Unit { int pm, pn; };
struct Gemm { const bf16_t* A; const bf16_t* Bt; int M, N, K; };

struct StaticOrder {
    int nM, nN, nwg, G, c;
    __host__ __device__ void init(int M, int N, int G_, int c_) { nM = M / BM; nN = N / BM; nwg = nM * nN; G = G_; c = c_; }
    __host__ __device__ bool next(int i, Unit& u) const {
        const long L = (long)i * G + c; if (L >= nwg) return false;
        int wgid = (int)L; { const int q = nwg / NXCD, r = nwg % NXCD, xcd = wgid % NXCD, off = wgid / NXCD; wgid = (xcd < r ? xcd * (q + 1) : r * (q + 1) + (xcd - r) * q) + off; }
        const int nig = WGM * nN, gid = wgid / nig, fm = gid * WGM, gsz = (nM - fm) < WGM ? (nM - fm) : WGM;
        u.pm = fm + ((wgid % nig) % gsz); u.pn = (wgid % nig) / gsz; return true;
    }
    __device__ __forceinline__ void a_ready(const Unit&) const {}
    __device__ __forceinline__ void done(const Unit&) const {}
};

__device__ __forceinline__ unsigned cvt_pk_bf16(float lo, float hi) { unsigned r; asm volatile("v_cvt_pk_bf16_f32 %0, %1, %2" : "=v"(r) : "v"(lo), "v"(hi)); return r; }
typedef float f32x2 __attribute__((ext_vector_type(2)));
template <class Epi, class Sched, bool ALIGN_EPI = false, bool SP2 = false>
__device__ __forceinline__ void gemm_phase(PG8_LAS unsigned char* lds, const Gemm g, const Sched& S, const Epi& E) {
    int tid_ = threadIdx.x; asm volatile("" : "+v"(tid_));
    const int tid = tid_, wid = __builtin_amdgcn_readfirstlane(tid >> 6), lane = tid & 63, wr = wid >> 2, wc = wid & 3, fr = lane & 15, fq = lane >> 4;
    const int K = g.K, nt = K / BK;
    unsigned voffA[2], voffB[2];
#pragma unroll
    for (int i = 0; i < 2; ++i) { int R, C; stage_rc(tid * 16 + i * 8192, R, C); const int Rb = Epi::PERM ? ((R & ~31) + perm32(R & 31)) : R;
        voffA[i] = (unsigned)(R * K + C) * 2u; voffB[i] = (unsigned)(Rb * K + C) * 2u; }
    const size_t kstep = (size_t)(BK * 2);
    const size_t hstep = (size_t)HALF * K * 2;
    const size_t tstep = 2 * hstep;
    const unsigned ldsw = (unsigned)wid * 1024u;
    const int aoff = lds_byte(wr * 64 + fr, fq * 8), boff = lds_byte(wc * 32 + fr, fq * 8);
#define PG8_SA(b, h) (((b) * 2 + (h)) * HTB)
#define PG8_SB(b, h) ((4 + (b) * 2 + (h)) * HTB)
#define PG8_STAGE(bufoff, gbase, voff) do { _Pragma("unroll") for (int _i = 0; _i < 2; ++_i) \
        __builtin_amdgcn_global_load_lds((const unsigned*)((const char*)(gbase) + (voff)[_i]), (PG8_LAS unsigned*)(lds + (bufoff) + ldsw + _i * 8192), 16, 0, 0); } while (0)
#define PG8_LDA(dst, b, h) do { _Pragma("unroll") for (int m = 0; m < 4; ++m) _Pragma("unroll") for (int k = 0; k < 2; ++k) dst[m][k] = *(const PG8_LAS bf16x8*)(lds + PG8_SA(b, h) + aoff + m * 2048 + k * 1024); } while (0)
#define PG8_LDB(dst, b, h) do { _Pragma("unroll") for (int n = 0; n < 2; ++n) _Pragma("unroll") for (int k = 0; k < 2; ++k) dst[n][k] = *(const PG8_LAS bf16x8*)(lds + PG8_SB(b, h) + boff + n * 2048 + k * 1024); } while (0)
#define PG8_MMA(ai, bj, At, Bt) do { __builtin_amdgcn_s_setprio(1); _Pragma("unroll") for (int m = 0; m < 4; ++m) _Pragma("unroll") for (int n = 0; n < 2; ++n) _Pragma("unroll") for (int k = 0; k < 2; ++k) \
        acc[ai][bj][m][n] = __builtin_amdgcn_mfma_f32_16x16x32_bf16(Bt[n][k], At[m][k], acc[ai][bj][m][n], 0, 0, 0); __builtin_amdgcn_s_setprio(0); } while (0)
#define PG8_WAIT_V(n) asm volatile("s_waitcnt vmcnt(" #n ")" ::: "memory")
#define PG8_WAIT_L(n) asm volatile("s_waitcnt lgkmcnt(" #n ")" ::: "memory")
#define PG8_BAR __builtin_amdgcn_s_barrier()
#define PG8_SCHED __builtin_amdgcn_sched_barrier(0)
    Unit cur, nxt; int ui = 0;
    if (!S.next(0, cur)) return;
    f32x4 acc[2][2][4][2];
#pragma unroll
    for (int a = 0; a < 2; ++a)
#pragma unroll
        for (int b = 0; b < 2; ++b)
#pragma unroll
            for (int m = 0; m < 4; ++m)
#pragma unroll
                for (int n = 0; n < 2; ++n) acc[a][b][m][n] = (f32x4){0.f, 0.f, 0.f, 0.f};
    bf16x8 At[4][2], B0[2][2], B1[2][2];
    const char* cA = (const char*)g.A + (size_t)cur.pm * tstep; const char* cB = (const char*)g.Bt + (size_t)cur.pn * tstep;
    S.a_ready(cur);
    if constexpr (SP2) {
        PG8_STAGE(PG8_SB(0, 0), cB, voffB); PG8_STAGE(PG8_SB(0, 1), cB + hstep, voffB); PG8_STAGE(PG8_SA(0, 0), cA, voffA); PG8_STAGE(PG8_SA(0, 1), cA + hstep, voffA);
        if (wr == 1) PG8_BAR;
        PG8_WAIT_V(2); PG8_BAR;
        PG8_STAGE(PG8_SB(1, 0), cB + kstep, voffB); PG8_STAGE(PG8_SA(1, 0), cA + kstep, voffA); PG8_STAGE(PG8_SB(1, 1), cB + hstep + kstep, voffB);
        PG8_WAIT_V(6); PG8_BAR;
    } else {
        PG8_STAGE(PG8_SB(0, 0), cB, voffB); PG8_STAGE(PG8_SA(0, 0), cA, voffA); PG8_STAGE(PG8_SB(0, 1), cB + hstep, voffB); PG8_STAGE(PG8_SA(0, 1), cA + hstep, voffA);
        if (wr == 1) PG8_BAR;
        PG8_WAIT_V(4); PG8_BAR;
        PG8_STAGE(PG8_SB(1, 0), cB + kstep, voffB); PG8_STAGE(PG8_SA(1, 0), cA + kstep, voffA); PG8_STAGE(PG8_SB(1, 1), cB + hstep + kstep, voffB);
        PG8_WAIT_V(6); PG8_BAR;
    }
    for (;;) {
        const bool has_next = S.next(ui + 1, nxt);
        const char* nA = has_next ? (const char*)g.A + (size_t)nxt.pm * tstep : cA; const char* nB = has_next ? (const char*)g.Bt + (size_t)nxt.pn * tstep : cB;
        for (int t = 0; t < nt; t += 2) {
            const bool last = (t == nt - 2);
            const char* a1 = cA + (size_t)(t + 1) * kstep;
            const char* a2 = last ? nA : cA + (size_t)(t + 2) * kstep; const char* b2 = last ? nB : cB + (size_t)(t + 2) * kstep;
            const char* a3 = a2 + kstep; const char* b3 = b2 + kstep;
            if (last && has_next) S.a_ready(nxt);
            if constexpr (SP2) {
            PG8_LDB(B0, 0, 0); PG8_LDB(B1, 0, 1); PG8_SCHED; PG8_LDA(At, 0, 0); PG8_STAGE(PG8_SA(1, 1), a1 + hstep, voffA);
            PG8_WAIT_V(8); PG8_WAIT_L(0); PG8_BAR; PG8_MMA(0, 0, At, B0); PG8_MMA(0, 1, At, B1); PG8_BAR; PG8_SCHED;
            PG8_LDA(At, 0, 1); PG8_STAGE(PG8_SB(0, 0), b2, voffB); PG8_STAGE(PG8_SB(0, 1), b2 + hstep, voffB); PG8_STAGE(PG8_SA(0, 0), a2, voffA);
            PG8_WAIT_V(8); PG8_WAIT_L(0); PG8_BAR; PG8_MMA(1, 0, At, B0); PG8_MMA(1, 1, At, B1); PG8_BAR; PG8_SCHED;
            PG8_LDB(B0, 1, 0); PG8_LDB(B1, 1, 1); PG8_SCHED; PG8_LDA(At, 1, 0); PG8_STAGE(PG8_SA(0, 1), a2 + hstep, voffA);
            PG8_WAIT_V(8); PG8_WAIT_L(0); PG8_BAR; PG8_MMA(0, 0, At, B0); PG8_MMA(0, 1, At, B1); PG8_BAR; PG8_SCHED;
            PG8_LDA(At, 1, 1); PG8_STAGE(PG8_SB(1, 0), b3, voffB); PG8_STAGE(PG8_SB(1, 1), b3 + hstep, voffB); PG8_STAGE(PG8_SA(1, 0), a3, voffA);
            PG8_WAIT_V(8); PG8_WAIT_L(0); PG8_BAR; PG8_MMA(1, 0, At, B0); PG8_MMA(1, 1, At, B1); PG8_BAR; PG8_SCHED;
            } else {
            PG8_LDB(B0, 0, 0); PG8_SCHED; PG8_LDA(At, 0, 0); PG8_STAGE(PG8_SA(1, 1), a1 + hstep, voffA);
            PG8_WAIT_L(8); PG8_BAR; PG8_WAIT_L(0); PG8_MMA(0, 0, At, B0); PG8_BAR; PG8_SCHED;
            PG8_LDB(B1, 0, 1); PG8_STAGE(PG8_SB(0, 0), b2, voffB);
            PG8_BAR; PG8_WAIT_L(0); PG8_MMA(0, 1, At, B1); PG8_BAR;
            PG8_LDA(At, 0, 1); PG8_STAGE(PG8_SA(0, 0), a2, voffA);
            PG8_BAR; PG8_WAIT_L(0); PG8_MMA(1, 0, At, B0); PG8_BAR; PG8_SCHED;
            PG8_STAGE(PG8_SB(0, 1), b2 + hstep, voffB);
            PG8_WAIT_V(6); PG8_BAR; PG8_MMA(1, 1, At, B1); PG8_BAR;
            PG8_LDB(B0, 1, 0); PG8_SCHED; PG8_LDA(At, 1, 0); PG8_STAGE(PG8_SA(0, 1), a2 + hstep, voffA);
            PG8_WAIT_L(8); PG8_BAR; PG8_WAIT_L(0); PG8_MMA(0, 0, At, B0); PG8_BAR; PG8_SCHED;
            PG8_LDB(B1, 1, 1); PG8_STAGE(PG8_SB(1, 0), b3, voffB);
            PG8_BAR; PG8_WAIT_L(0); PG8_MMA(0, 1, At, B1); PG8_BAR;
            PG8_LDA(At, 1, 1); PG8_STAGE(PG8_SA(1, 0), a3, voffA);
            PG8_BAR; PG8_WAIT_L(0); PG8_MMA(1, 0, At, B0); PG8_BAR; PG8_SCHED;
            PG8_STAGE(PG8_SB(1, 1), b3 + hstep, voffB);
            PG8_WAIT_V(6); PG8_BAR; PG8_MMA(1, 1, At, B1); PG8_BAR;
            }
        }
        if constexpr (ALIGN_EPI) { if (wr == 0) PG8_BAR; }
        if constexpr (!Epi::AFTER_DRAIN) { E(acc, cur, wr, wc, fr, fq); S.done(cur); }
        if (!has_next) break;
#pragma unroll
        for (int a = 0; a < 2; ++a)
#pragma unroll
            for (int b = 0; b < 2; ++b)
#pragma unroll
                for (int m = 0; m < 4; ++m)
#pragma unroll
                    for (int n = 0; n < 2; ++n) acc[a][b][m][n] = (f32x4){0.f, 0.f, 0.f, 0.f};
        cur = nxt; cA = nA; cB = nB; ++ui;
        if constexpr (ALIGN_EPI) { if (wr == 1) PG8_BAR; }
    }
    PG8_WAIT_V(0);
    if constexpr (!ALIGN_EPI) { if (wr == 0) PG8_BAR; }
    PG8_BAR;
    if constexpr (Epi::AFTER_DRAIN) { E.fused(acc, cur, wr, wc, fr, fq, lds, wid, lane); S.done(cur); }
#undef PG8_SA
#undef PG8_SB
#undef PG8_STAGE
#undef PG8_LDA
#undef PG8_LDB
#undef PG8_MMA
#undef PG8_WAIT_V
#undef PG8_WAIT_L
#undef PG8_BAR
#undef PG8_SCHED
}
}

#define LAS __attribute__((address_space(3)))
typedef unsigned short bf16;
typedef unsigned v4u __attribute__((ext_vector_type(4)));
typedef unsigned v2u __attribute__((ext_vector_type(2)));
typedef float f32x4 __attribute__((ext_vector_type(4)));
typedef short bf16x8 __attribute__((ext_vector_type(8)));
typedef LAS unsigned char* ldsp;

constexpr int M = 16384, D = 2048, FF = 5632, NFF = 2 * FF, NIN = 3584, PW = 3072, SEQ = 4096;
constexpr float EPS = 1e-5f, LOG2E = 1.4426950408889634f;
constexpr int NTHREADS = 512, NWAVES = 8;
constexpr int LDS_BYTES = 147456;

constexpr size_t MiB = 1u << 20;
constexpr size_t WS_SS = 1 * MiB;
constexpr size_t WS_CS = 2 * MiB;
constexpr size_t WS_W = 4 * MiB;
constexpr size_t WL_F1I = 0, WL_F1O = 44 * MiB, WL_IN = 66 * MiB, WL_OUT = 80 * MiB, WL_F2I = 88 * MiB, WL_F2O = 132 * MiB, WL_SIZE = 154 * MiB;
constexpr size_t WS_XB = WS_W + 2 * WL_SIZE;
constexpr size_t WS_ACT = WS_XB + 64 * MiB;
constexpr size_t WS_P = WS_ACT, WS_MX = WS_ACT + 96 * MiB;
constexpr size_t WS_PART = WS_ACT + 176 * MiB;
constexpr size_t WS_END = WS_PART + 16 * MiB;

__device__ __forceinline__ float bflo(unsigned u) { return __uint_as_float(u << 16); }
__device__ __forceinline__ float bfhi(unsigned u) { return __uint_as_float(u & 0xffff0000u); }
__device__ __forceinline__ unsigned pk(float lo, float hi) { return pg8::cvt_pk_bf16(lo, hi); }
__device__ __forceinline__ float wave_sum(float v) {
    v += __builtin_bit_cast(float, __builtin_amdgcn_update_dpp(0, __builtin_bit_cast(int, v), 0x111, 0xf, 0xf, true));
    v += __builtin_bit_cast(float, __builtin_amdgcn_update_dpp(0, __builtin_bit_cast(int, v), 0x112, 0xf, 0xf, true));
    v += __builtin_bit_cast(float, __builtin_amdgcn_update_dpp(0, __builtin_bit_cast(int, v), 0x114, 0xf, 0xf, true));
    v += __builtin_bit_cast(float, __builtin_amdgcn_update_dpp(0, __builtin_bit_cast(int, v), 0x118, 0xf, 0xf, true));
    v += __builtin_bit_cast(float, __builtin_amdgcn_update_dpp(0, __builtin_bit_cast(int, v), 0x142, 0xa, 0xf, false));
    v += __builtin_bit_cast(float, __builtin_amdgcn_update_dpp(0, __builtin_bit_cast(int, v), 0x143, 0xc, 0xf, false));
    return __builtin_bit_cast(float, __builtin_amdgcn_readlane(__builtin_bit_cast(int, v), 63));
}
__device__ __forceinline__ float fast_sigmoid(float x) { return __builtin_amdgcn_rcpf(1.0f + __builtin_amdgcn_exp2f(-x * LOG2E)); }

struct EpiSwiGLU {
    static constexpr bool PERM = true, AFTER_DRAIN = false;
    bf16* O; const LAS float* rtab; int rowbase;
    __device__ __forceinline__ void operator()(const f32x4 (&acc)[2][2][4][2], const pg8::Unit& u, int wr, int wc, int fr, int fq) const {
        const int row0 = u.pm * 256 + wr * 64 + fr, col0 = u.pn * 128 + wc * 32 + 8 * fq;
        float rr[8];
#pragma unroll
        for (int k = 0; k < 8; ++k) rr[k] = rtab[(row0 + (k >> 2) * 128 + (k & 3) * 16 - rowbase) & 2047];
#pragma unroll
        for (int ai = 0; ai < 2; ++ai)
#pragma unroll
            for (int m = 0; m < 4; ++m) {
                const int row = row0 + ai * 128 + m * 16;
                const float r = rr[ai * 4 + m];
                float o[8];
#pragma unroll
                for (int n = 0; n < 2; ++n)
#pragma unroll
                    for (int i = 0; i < 4; ++i) { const float g = acc[ai][0][m][n][i] * r, uu = acc[ai][1][m][n][i] * r; o[4 * n + i] = g * fast_sigmoid(g) * uu; }
                v4u w; w.x = pk(o[0], o[1]); w.y = pk(o[2], o[3]); w.z = pk(o[4], o[5]); w.w = pk(o[6], o[7]);
                *(v4u*)(O + (size_t)row * FF + col0) = w;
            }
    }
};
struct EpiResid {
    static constexpr bool PERM = true, AFTER_DRAIN = false;
    bf16* xb; float* part_out; float scale;
    __device__ __forceinline__ void operator()(const f32x4 (&acc)[2][2][4][2], const pg8::Unit& u, int wr, int wc, int fr, int fq) const {
        const int row0 = u.pm * 256 + wr * 64 + fr, col0 = u.pn * 256 + wc * 32 + 8 * fq;
#pragma unroll
        for (int ai = 0; ai < 2; ++ai) {
            v4u bs[4][2];
#pragma unroll
            for (int m = 0; m < 4; ++m)
#pragma unroll
                for (int bj = 0; bj < 2; ++bj) bs[m][bj] = *(const v4u*)(xb + (size_t)(row0 + ai * 128 + m * 16) * D + col0 + bj * 128);
#pragma unroll
            for (int m = 0; m < 4; ++m) {
                const int row = row0 + ai * 128 + m * 16; float sq = 0.f;
#pragma unroll
                for (int bj = 0; bj < 2; ++bj) {
                    const size_t off = (size_t)row * D + col0 + bj * 128;
                    const v4u b = bs[m][bj];
                    const f32x4 b0 = {bflo(b.x), bfhi(b.x), bflo(b.y), bfhi(b.y)}, b1 = {bflo(b.z), bfhi(b.z), bflo(b.w), bfhi(b.w)};
                    const f32x4 x0 = b0 + acc[ai][bj][m][0] * scale, x1 = b1 + acc[ai][bj][m][1] * scale;
                    v4u w; w.x = pk(x0[0], x0[1]); w.y = pk(x0[2], x0[3]); w.z = pk(x1[0], x1[1]); w.w = pk(x1[2], x1[3]);
                    *(v4u*)(xb + off) = w;
                    sq += (x0[0] * x0[0] + x0[1] * x0[1]) + (x0[2] * x0[2] + x0[3] * x0[3]) + (x1[0] * x1[0] + x1[1] * x1[1]) + (x1[2] * x1[2] + x1[3] * x1[3]);
                }
                sq += __shfl_xor(sq, 16); sq += __shfl_xor(sq, 32);
                if (fq == 0) part_out[(size_t)row * 32 + u.pn * 4 + wc] = sq;
            }
            asm volatile("" ::: "memory");
        }
    }
};
struct EpiMixIn {
    static constexpr bool PERM = true, AFTER_DRAIN = false;
    bf16* P; const LAS float* rtab; int rowbase; const float* cs;
    __device__ __forceinline__ void operator()(const f32x4 (&acc)[2][2][4][2], const pg8::Unit& u, int wr, int wc, int fr, int fq) const {
        const int row0 = u.pm * 256 + wr * 64 + fr, pn = u.pn, lc = wc * 32 + 8 * fq;
        float rr[8];
#pragma unroll
        for (int k = 0; k < 8; ++k) rr[k] = rtab[(row0 + (k >> 2) * 128 + (k & 3) * 16 - rowbase) & 2047];
#pragma unroll
        for (int ai = 0; ai < 2; ++ai)
#pragma unroll
            for (int m = 0; m < 4; ++m) {
                const int row = row0 + ai * 128 + m * 16;
                const float r = rr[ai * 4 + m];
                f32x4 a0 = acc[ai][0][m][0] * r, a1 = acc[ai][0][m][1] * r, b0 = acc[ai][1][m][0] * r, b1 = acc[ai][1][m][1] * r;
                bf16* prow = P + (size_t)row * PW;
                if (pn >= 6 && pn < 10) {
                    float o[8];
#pragma unroll
                    for (int i = 0; i < 4; ++i) { o[i] = a0[i] * fast_sigmoid(b0[i]); o[4 + i] = a1[i] * fast_sigmoid(b1[i]); }
                    v4u w; w.x = pk(o[0], o[1]); w.y = pk(o[2], o[3]); w.z = pk(o[4], o[5]); w.w = pk(o[6], o[7]);
                    *(v4u*)(prow + 1536 + 128 * (pn - 6) + lc) = w;
                } else {
                    if (pn < 5) {
                        if ((wc & 1) == 0) {
                            f32x4 pa0, pa1, pb0, pb1;
#pragma unroll
                            for (int i = 0; i < 4; ++i) { pa0[i] = __shfl_xor(a0[i], 16); pa1[i] = __shfl_xor(a1[i], 16); pb0[i] = __shfl_xor(b0[i], 16); pb1[i] = __shfl_xor(b1[i], 16); }
                            if (fq < 2) {
                                const float* c = cs + (size_t)row * 16;
                                const f32x4 c0 = *(const f32x4*)c, c1 = *(const f32x4*)(c + 4); f32x4 s0 = *(const f32x4*)(c + 8), s1 = *(const f32x4*)(c + 12);
                                if (fq == 0) { s0 = -s0; s1 = -s1; }
                                a0 = a0 * c0 + pa0 * s0; a1 = a1 * c1 + pa1 * s1; b0 = b0 * c0 + pb0 * s0; b1 = b1 * c1 + pb1 * s1;
                            }
                        }
                        if (pn < 4) { a0 = a0 * 0.125f; a1 = a1 * 0.125f; b0 = b0 * 0.125f; b1 = b1 * 0.125f; }
                    }
                    const int cb = (pn <= 5 ? 256 * pn : 256 * pn - 512) + lc;
                    v4u w; w.x = pk(a0[0], a0[1]); w.y = pk(a0[2], a0[3]); w.z = pk(a1[0], a1[1]); w.w = pk(a1[2], a1[3]);
                    *(v4u*)(prow + cb) = w;
                    v4u z; z.x = pk(b0[0], b0[1]); z.y = pk(b0[2], b0[3]); z.z = pk(b1[0], b1[1]); z.w = pk(b1[2], b1[3]);
                    *(v4u*)(prow + cb + 128) = z;
                }
                if (m & 1) asm volatile("" ::: "memory");
            }
    }
};

__device__ __forceinline__ void transpose_item(const float* W, int K, int N, const float* g, bf16* WT, int k0, int n0, int sn0, LAS unsigned* scr, int lane) {
    const int c4 = lane & 31, ph = lane >> 5;
    const float* src = W + (size_t)(k0 + 2 * ph) * N + sn0 + 4 * c4;
    f32x4 ra[16], rb[16];
#pragma unroll
    for (int i = 0; i < 16; ++i) { ra[i] = *(const f32x4*)(src + (size_t)(4 * i) * N); rb[i] = *(const f32x4*)(src + (size_t)(4 * i + 1) * N); }
#pragma unroll
    for (int i = 0; i < 16; ++i) {
        const int p = ph + 2 * i;
        float ga = 1.f, gb = 1.f; if (g) { ga = g[k0 + 2 * p]; gb = g[k0 + 2 * p + 1]; }
        LAS unsigned* d = scr + p * 129 + c4;
        d[0] = pk(ra[i][0] * ga, rb[i][0] * gb); d[32] = pk(ra[i][1] * ga, rb[i][1] * gb); d[64] = pk(ra[i][2] * ga, rb[i][2] * gb); d[96] = pk(ra[i][3] * ga, rb[i][3] * gb);
    }
    asm volatile("s_waitcnt lgkmcnt(0)" ::: "memory");
    const int c = lane & 7, q = lane >> 3;
#pragma unroll
    for (int j = 0; j < 16; ++j) {
        const int n = 4 * ((q & 3) + 4 * (j >> 1)) + ((q >> 2) + 2 * (j & 1));
        const LAS unsigned* sp = scr + (4 * c) * 129 + (n & 3) * 32 + (n >> 2);
        v4u o; o.x = sp[0]; o.y = sp[129]; o.z = sp[258]; o.w = sp[387];
        *(v4u*)(WT + (size_t)(n0 + n) * K + k0 + 8 * c) = o;
    }
    asm volatile("s_waitcnt lgkmcnt(0)" ::: "memory");
}
__device__ __forceinline__ int src_col(int mode, int n0) {
    if (mode == 1) return ((n0 >> 7) & 1) * FF + 128 * (n0 >> 8) + (n0 & 127);
    if (mode == 2) { const int pn = n0 >> 8; if (pn >= 6 && pn < 10) return 1536 + 512 * ((n0 >> 7) & 1) + 128 * (pn - 6) + (n0 & 127); }
    return n0;
}
__device__ __forceinline__ void convert_matrix(const float* W, int K, int N, const float* g, bf16* WT, int mode, int item, LAS unsigned* scr, int lane) {
    const int nblk = N / 128, kb = item / nblk, nb = item % nblk;
    transpose_item(W, K, N, g, WT, 64 * kb, 128 * nb, src_col(mode, 128 * nb), scr, lane);
}

struct Args {
    const float* x; const int* pos;
    const float *norm_ffn1, *ffn1_w_in, *ffn1_w_out, *norm_mix, *w_in, *conv_dw_w, *conv_dw_b, *conv_ln_g, *conv_ln_b, *sgu_ln_g, *sgu_ln_b, *sgu_w, *sgu_b, *attn_sinks, *w_out,
        *norm_ffn2, *ffn2_w_in, *ffn2_w_out, *final_norm;
    float* out; unsigned char* ws;
};

__device__ __forceinline__ void prologue(const Args& a, ldsp lds, int gw, int NGW, int lane, int wave) {
    LAS unsigned* scr = (LAS unsigned*)(lds + wave * 16640);
    constexpr int I_FI = (D / 64) * (NFF / 128), I_FO = (FF / 64) * (D / 128), I_IN = (D / 64) * (NIN / 128), I_OUT = (D / 64) * (D / 128);
    constexpr int I_LAYER = 2 * I_FI + 2 * I_FO + I_IN + I_OUT;
    for (int it = gw; it < 2 * I_LAYER; it += NGW) {
        const int l = it / I_LAYER; int r = it % I_LAYER;
        unsigned char* wl = a.ws + WS_W + (size_t)l * WL_SIZE;
        if (r < I_FI) { convert_matrix(a.ffn1_w_in + (size_t)l * D * NFF, D, NFF, a.norm_ffn1 + l * D, (bf16*)(wl + WL_F1I), 1, r, scr, lane); continue; } r -= I_FI;
        if (r < I_FI) { convert_matrix(a.ffn2_w_in + (size_t)l * D * NFF, D, NFF, a.norm_ffn2 + l * D, (bf16*)(wl + WL_F2I), 1, r, scr, lane); continue; } r -= I_FI;
        if (r < I_IN) { convert_matrix(a.w_in + (size_t)l * D * NIN, D, NIN, a.norm_mix + l * D, (bf16*)(wl + WL_IN), 2, r, scr, lane); continue; } r -= I_IN;
        if (r < I_FO) { convert_matrix(a.ffn1_w_out + (size_t)l * FF * D, FF, D, nullptr, (bf16*)(wl + WL_F1O), 0, r, scr, lane); continue; } r -= I_FO;
        if (r < I_FO) { convert_matrix(a.ffn2_w_out + (size_t)l * FF * D, FF, D, nullptr, (bf16*)(wl + WL_F2O), 0, r, scr, lane); continue; } r -= I_FO;
        convert_matrix(a.w_out + (size_t)l * D * D, D, D, nullptr, (bf16*)(wl + WL_OUT), 0, r, scr, lane);
    }
}

__device__ __forceinline__ void prologue_rows(const Args& a, int gw, int NGW, int lane, int gtid, int NGT) {
    bf16* XB = (bf16*)(a.ws + WS_XB); float* part0 = (float*)(a.ws + WS_PART);
    for (int m = gw; m < M; m += NGW) {
        const f32x4* xr = (const f32x4*)(a.x + (size_t)m * D) + lane; v2u* o8 = (v2u*)(XB + (size_t)m * D) + lane; float s = 0.f;
#pragma unroll
        for (int j = 0; j < 8; ++j) { const f32x4 v = xr[64 * j]; s += (v[0] * v[0] + v[1] * v[1]) + (v[2] * v[2] + v[3] * v[3]); v2u w; w.x = pk(v[0], v[1]); w.y = pk(v[2], v[3]); o8[64 * j] = w; }
        s = wave_sum(s);
        if (lane < 32) part0[(size_t)m * 32 + lane] = (lane == 0) ? s : 0.f;
    }
    float* cs = (float*)(a.ws + WS_CS);
    for (int i = gtid; i < M * 8; i += NGT) {
        const int m = i >> 3, f = i & 7;
        const float invf[8] = {1.0f, 0.193922758102417f, 0.03760603070259094f, 0.00729266507551074f, 0.001414213445968926f, 0.00027424818836152554f, 5.318296462064609e-05f, 1.0313385246263351e-05f};
        float fr_ = invf[0];
#pragma unroll
        for (int k = 1; k < 8; ++k) fr_ = (f == k) ? invf[k] : fr_;
        const float ang = (float)a.pos[m] * fr_;
        double t = (double)ang * 0.15915494309189533577; t -= __builtin_rint(t);
        const float tf = (float)t;
        cs[(size_t)m * 16 + f] = __builtin_amdgcn_cosf(tf); cs[(size_t)m * 16 + 8 + f] = __builtin_amdgcn_sinf(tf);
    }
}

#define MFMA16(a, b, c) __builtin_amdgcn_mfma_f32_16x16x32_bf16(a, b, c, 0, 0, 0)

__device__ __forceinline__ void attn_unit(ldsp lds, const bf16* P, bf16* MX, const float* sinks, int b, int n, int g, int tid) {
    const int lane = tid & 63, wid = tid >> 6, fr = lane & 15, fq = lane >> 4;
    ldsp Kl = lds; ldsp Vl = lds + 36864;
    const int tok0 = b * SEQ + n * 128;
    const int hq = 4 * g + (wid >> 1), half = wid & 1;
    v4u kvr[4], vvr[4];
#pragma unroll
    for (int i = 0; i < 4; ++i) {
        const int p = tid + 512 * i, key = p >> 3, ch = p & 7;
        kvr[i] = (v4u){0u, 0u, 0u, 0u}; vvr[i] = (v4u){0u, 0u, 0u, 0u};
        if (n > 0 || key >= 128) { const bf16* src = P + (size_t)(tok0 - 128 + key) * PW + 64 * g + 8 * ch; kvr[i] = *(const v4u*)(src + 1024); vvr[i] = *(const v4u*)(src + 1280); }
    }
    const bf16* qbase = P + (size_t)(tok0 + 64 * half + fr) * PW + 64 * hq + 8 * fq;
    bf16x8 qn0 = *(const bf16x8*)qbase, qn1 = *(const bf16x8*)(qbase + 32);
    const float sink = sinks[hq];
#pragma unroll
    for (int i = 0; i < 4; ++i) {
        const int p = tid + 512 * i, key = p >> 3, ch = p & 7;
        *(LAS v4u*)(Kl + key * 144 + ch * 16) = kvr[i];
#pragma unroll
        for (int j = 0; j < 8; ++j) { const unsigned e = (vvr[i][j >> 1] >> (16 * (j & 1))) & 0xffffu; *(LAS unsigned short*)(Vl + (8 * ch + j) * 528 + key * 2) = (unsigned short)e; }
    }
    __syncthreads();
#pragma unroll 1
    for (int mt = 0; mt < 4; ++mt) {
        const int mp = 4 * half + mt;
        const bf16x8 q0 = qn0, q1 = qn1;
        { const bf16* qnx = qbase + (size_t)(16 * (mt < 3 ? mt + 1 : 3)) * PW; qn0 = *(const bf16x8*)qnx; qn1 = *(const bf16x8*)(qnx + 32); }
        f32x4 s[9];
#pragma unroll
        for (int kt = 0; kt < 9; ++kt) {
            ldsp kp = Kl + (16 * (mp + kt) + fr) * 144 + fq * 16;
            const bf16x8 k0 = *(const LAS bf16x8*)kp, k1 = *(const LAS bf16x8*)(kp + 64);
            f32x4 z = {0.f, 0.f, 0.f, 0.f};
            z = MFMA16(k0, q0, z); z = MFMA16(k1, q1, z); s[kt] = z;
        }
#pragma unroll
        for (int i = 0; i < 4; ++i) { if (!(4 * fq + i > fr)) s[0][i] = -1e30f; if (!(4 * fq + i <= fr)) s[8][i] = -1e30f; }
        if (n == 0) {
#pragma unroll
            for (int kt = 0; kt < 8; ++kt) if (mp + kt < 8) s[kt] = (f32x4){-1e30f, -1e30f, -1e30f, -1e30f};
        }
        float mx = sink;
#pragma unroll
        for (int kt = 0; kt < 9; ++kt) mx = fmaxf(mx, fmaxf(fmaxf(s[kt][0], s[kt][1]), fmaxf(s[kt][2], s[kt][3])));
        mx = fmaxf(mx, __shfl_xor(mx, 16)); mx = fmaxf(mx, __shfl_xor(mx, 32));
        float sum = 0.f; const float mxl = mx * LOG2E;
#pragma unroll
        for (int kt = 0; kt < 9; ++kt)
#pragma unroll
            for (int i = 0; i < 4; ++i) { const float p = __builtin_amdgcn_exp2f(s[kt][i] * LOG2E - mxl); s[kt][i] = p; sum += p; }
        sum += __shfl_xor(sum, 16); sum += __shfl_xor(sum, 32);
        sum += __builtin_amdgcn_exp2f(sink * LOG2E - mxl);
        const float inv = 1.0f / sum;
        f32x4 o[4];
#pragma unroll
        for (int nd = 0; nd < 4; ++nd) o[nd] = (f32x4){0.f, 0.f, 0.f, 0.f};
#pragma unroll
        for (int sp = 0; sp < 5; ++sp) {
            const int tA = mp + 2 * sp, tB = (sp < 4) ? tA + 1 : tA;
            v4u pw; pw.x = pk(s[2 * sp][0], s[2 * sp][1]); pw.y = pk(s[2 * sp][2], s[2 * sp][3]);
            const int iB = (sp < 4) ? 2 * sp + 1 : 8;
            if (sp < 4) { pw.z = pk(s[iB][0], s[iB][1]); pw.w = pk(s[iB][2], s[iB][3]); } else { pw.z = 0u; pw.w = 0u; }
            const bf16x8 pf = __builtin_bit_cast(bf16x8, pw);
#pragma unroll
            for (int nd = 0; nd < 4; ++nd) {
                ldsp vr = Vl + (16 * nd + fr) * 528 + 8 * fq;
                v4u vw; const v2u va = *(const LAS v2u*)(vr + 32 * tA), vb = *(const LAS v2u*)(vr + 32 * tB);
                vw.x = va.x; vw.y = va.y; vw.z = vb.x; vw.w = vb.y;
                o[nd] = MFMA16(__builtin_bit_cast(bf16x8, vw), pf, o[nd]);
            }
        }
        bf16* orow = MX + (size_t)(tok0 + 16 * mp + fr) * D + 64 * hq + 4 * fq;
#pragma unroll
        for (int nd = 0; nd < 4; ++nd) { v2u w; w.x = pk(o[nd][0] * inv, o[nd][1] * inv); w.y = pk(o[nd][2] * inv, o[nd][3] * inv); *(v2u*)(orow + 16 * nd) = w; }
    }
    __syncthreads();
}

typedef float f32x2 __attribute__((ext_vector_type(2)));
__device__ __forceinline__ void conv_unit(ldsp lds, const bf16* P, bf16* MX, const float* dw_w, const float* dw_b, const float* ln_g, const float* ln_b, int cu, int tid) {
    const int lane = tid & 63, wid = tid >> 6;
    const int tok0 = 32 * cu, s0 = tok0 & (SEQ - 1);
    ldsp Wl = lds + 65536;
    v4u st[8]; f32x4 sw[8];
#pragma unroll
    for (int i = 0; i < 8; ++i) {
        const int p = tid + NTHREADS * i, r = p >> 6, c = p & 63; st[i] = (v4u){0u, 0u, 0u, 0u};
        if (p < 3968 && s0 - 30 + r >= 0) st[i] = *(const v4u*)(P + (size_t)(tok0 - 30 + r) * PW + 1536 + 8 * c);
        sw[i] = (f32x4){0.f, 0.f, 0.f, 0.f};
        if (p < 3968) sw[i] = *(const f32x4*)(dw_w + 4 * p);
    }
#pragma unroll
    for (int i = 0; i < 8; ++i) {
        const int p = tid + NTHREADS * i, r = p >> 6, c = p & 63;
        if (p < 3968) { *(LAS v4u*)(lds + r * 1040 + c * 16) = st[i]; *(LAS f32x4*)(Wl + p * 16) = sw[i]; }
    }
    __syncthreads();
    const int c0 = 8 * lane;
    f32x2 acc[4][4];
#pragma unroll
    for (int t = 0; t < 4; ++t)
#pragma unroll
        for (int k = 0; k < 4; ++k) acc[t][k] = (f32x2){0.f, 0.f};
    ldsp rb = lds + (4 * wid) * 1040 + lane * 16; ldsp wb = Wl + lane * 32;
#pragma unroll 1
    for (int j = 0; j < 31; ++j) {
        const f32x4 w0 = *(const LAS f32x4*)(wb + j * 2048), w1 = *(const LAS f32x4*)(wb + j * 2048 + 16);
        const f32x2 wv[4] = {{w0[0], w0[1]}, {w0[2], w0[3]}, {w1[0], w1[1]}, {w1[2], w1[3]}};
#pragma unroll
        for (int t = 0; t < 4; ++t) {
            const v4u hv = *(const LAS v4u*)(rb + (t + j) * 1040);
#pragma unroll
            for (int k = 0; k < 4; ++k) { const f32x2 h2 = {bflo(hv[k]), bfhi(hv[k])}; acc[t][k] += h2 * wv[k]; }
        }
    }
    const f32x4 bb0 = *(const f32x4*)(dw_b + c0), bb1 = *(const f32x4*)(dw_b + c0 + 4), g0 = *(const f32x4*)(ln_g + c0), g1 = *(const f32x4*)(ln_g + c0 + 4), e0 = *(const f32x4*)(ln_b + c0), e1 = *(const f32x4*)(ln_b + c0 + 4);
#pragma unroll
    for (int t = 0; t < 4; ++t) {
        f32x4 y0 = (f32x4){acc[t][0][0], acc[t][0][1], acc[t][1][0], acc[t][1][1]} + bb0, y1 = (f32x4){acc[t][2][0], acc[t][2][1], acc[t][3][0], acc[t][3][1]} + bb1;
        const float s = (y0[0] + y0[1]) + (y0[2] + y0[3]) + (y1[0] + y1[1]) + (y1[2] + y1[3]);
        const float mean = wave_sum(s) * (1.0f / 512.0f);
        y0 = y0 - mean; y1 = y1 - mean;
        const float q = (y0[0] * y0[0] + y0[1] * y0[1]) + (y0[2] * y0[2] + y0[3] * y0[3]) + (y1[0] * y1[0] + y1[1] * y1[1]) + (y1[2] * y1[2] + y1[3] * y1[3]);
        const float rstd = __builtin_amdgcn_rsqf(wave_sum(q) * (1.0f / 512.0f) + EPS);
        y0 = y0 * rstd * g0 + e0; y1 = y1 * rstd * g1 + e1;
#pragma unroll
        for (int c = 0; c < 4; ++c) { y0[c] = y0[c] * fast_sigmoid(y0[c]); y1[c] = y1[c] * fast_sigmoid(y1[c]); }
        v4u w; w.x = pk(y0[0], y0[1]); w.y = pk(y0[2], y0[3]); w.z = pk(y1[0], y1[1]); w.w = pk(y1[2], y1[3]);
        *(v4u*)(MX + (size_t)(tok0 + 4 * wid + t) * D + 1024 + c0) = w;
    }
    __syncthreads();
}

__device__ __forceinline__ void sgu_unit(ldsp lds, const bf16* P, bf16* MX, const float* ln_g, const float* ln_b, const float* w_s, const float* b_s, int ck, int hf, int tid) {
    const int lane = tid & 63, wid = tid >> 6, fr = lane & 15, fq = lane >> 4;
    const int tok0 = 128 * ck, c0 = 8 * lane;
    const int hl = wid >> 1, hh = 4 * hf + hl, th = wid & 1;
    {
        const f32x4 g0 = *(const f32x4*)(ln_g + c0), g1 = *(const f32x4*)(ln_g + c0 + 4), e0 = *(const f32x4*)(ln_b + c0), e1 = *(const f32x4*)(ln_b + c0 + 4);
#pragma unroll 1
        for (int i4 = 0; i4 < 16; i4 += 4) {
        v4u raw4[4];
#pragma unroll
        for (int i = 0; i < 4; ++i) raw4[i] = *(const v4u*)(P + (size_t)(tok0 + 16 * wid + i4 + i) * PW + 2560 + c0);
#pragma unroll
        for (int i = 0; i < 4; ++i) {
            const int sidx = 16 * wid + i4 + i; const v4u rw = raw4[i];
            float v[8] = {bflo(rw.x), bfhi(rw.x), bflo(rw.y), bfhi(rw.y), bflo(rw.z), bfhi(rw.z), bflo(rw.w), bfhi(rw.w)};
            float s = 0.f;
#pragma unroll
            for (int c = 0; c < 8; ++c) s += v[c];
            const float mean = wave_sum(s) * (1.0f / 512.0f); float q = 0.f;
#pragma unroll
            for (int c = 0; c < 8; ++c) { v[c] -= mean; q += v[c] * v[c]; }
            const float rstd = __builtin_amdgcn_rsqf(wave_sum(q) * (1.0f / 512.0f) + EPS);
            if ((lane >> 5) == hf) {
#pragma unroll
                for (int c = 0; c < 8; ++c) { const float vn = v[c] * rstd * (c < 4 ? g0[c & 3] : g1[c & 3]) + (c < 4 ? e0[c & 3] : e1[c & 3]);
                    *(LAS unsigned short*)(lds + ((c0 & 255) + c) * 272 + 2 * sidx) = (unsigned short)(pk(vn, 0.f) & 0xffffu); }
            }
        }
        }
    }
    __syncthreads();
#pragma unroll 1
    for (int m = 0; m < 4; ++m) {
        const int t0 = 64 * th + 16 * m, t = t0 + fr;
        f32x4 acc[4];
#pragma unroll
        for (int nd = 0; nd < 4; ++nd) acc[nd] = (f32x4){0.f, 0.f, 0.f, 0.f};
        const float* wrow = w_s + ((size_t)hh * 128 + t) * 128;
        const int nks = (t0 + 15) / 32 + 1;
        f32x4 wa[4], wb[4];
#pragma unroll
        for (int ks = 0; ks < 4; ++ks) { const int kk = ks < nks ? ks : 0; wa[ks] = *(const f32x4*)(wrow + 32 * kk + 8 * fq); wb[ks] = *(const f32x4*)(wrow + 32 * kk + 8 * fq + 4); }
        const float bias = b_s[hh * 128 + t];
        v2u uu[4];
#pragma unroll
        for (int nd = 0; nd < 4; ++nd) uu[nd] = *(const v2u*)(P + (size_t)(tok0 + t) * PW + 2048 + 64 * hh + 16 * nd + 4 * fq);
#pragma unroll
        for (int ks = 0; ks < 4; ++ks) {
            if (ks < nks) {
                const int sb = 32 * ks + 8 * fq;
                f32x4 xa = wa[ks], xb = wb[ks];
#pragma unroll
                for (int i = 0; i < 4; ++i) { xa[i] = (sb + i <= t) ? xa[i] : 0.f; xb[i] = (sb + 4 + i <= t) ? xb[i] : 0.f; }
                v4u ww; ww.x = pk(xa[0], xa[1]); ww.y = pk(xa[2], xa[3]); ww.z = pk(xb[0], xb[1]); ww.w = pk(xb[2], xb[3]);
                const bf16x8 wf = __builtin_bit_cast(bf16x8, ww);
#pragma unroll
                for (int nd = 0; nd < 4; ++nd) {
                    const bf16x8 vf = *(const LAS bf16x8*)(lds + (64 * hl + 16 * nd + fr) * 272 + 64 * ks + 16 * fq);
                    acc[nd] = MFMA16(vf, wf, acc[nd]);
                }
            }
        }
#pragma unroll
        for (int nd = 0; nd < 4; ++nd) {
            const int ch = 64 * hh + 16 * nd + 4 * fq;
            v2u w; w.x = pk((acc[nd][0] + bias) * bflo(uu[nd].x), (acc[nd][1] + bias) * bfhi(uu[nd].x)); w.y = pk((acc[nd][2] + bias) * bflo(uu[nd].y), (acc[nd][3] + bias) * bfhi(uu[nd].y));
            *(v2u*)(MX + (size_t)(tok0 + t) * D + 1536 + ch) = w;
        }
    }
    __syncthreads();
}

#define XB_TMO      128
#define XB_XCNT(j)  (256  + 64 * (j))
#define XB_XSUB(j)  (1280 + 64 * (j))
#define XB_XGEN(j)  (2304 + 64 * (j))
#define XB_TOP      3328
#define XB_TOPGEN   3392
#define XCD_BAR_WORDS 3456
#define XB_SPIN_CAP (1u << 23)

__device__ __forceinline__ unsigned xb_ld(unsigned* p)              { return __hip_atomic_load(p, __ATOMIC_RELAXED, __HIP_MEMORY_SCOPE_AGENT); }
__device__ __forceinline__ unsigned xb_add(unsigned* p, unsigned v) { return __hip_atomic_fetch_add(p, v, __ATOMIC_RELAXED, __HIP_MEMORY_SCOPE_AGENT); }
__device__ __forceinline__ unsigned xb_xcc_id() { return (unsigned)__builtin_amdgcn_s_getreg((3 << 11) | 20) & 0xFu; }
#define XB_SPIN(cond, bar) do { unsigned _sp = 0; while (cond) { __builtin_amdgcn_s_sleep(1); \
    if ((++_sp & 255u) == 0u) { if (xb_ld(&(bar)[XB_TMO])) break; if (_sp > XB_SPIN_CAP) { atomicAdd(&(bar)[XB_TMO], 1u); break; } } } } while (0)

struct XcdBarrier {
    unsigned* bar; unsigned x;
    volatile LAS unsigned* st;
};

__device__ __forceinline__ XcdBarrier xcd_barrier_post(unsigned* bar, volatile LAS unsigned* st) {
    XcdBarrier b; b.bar = bar; b.x = xb_xcc_id(); b.st = st;
    if (threadIdx.x == 0) (void)xb_add(&bar[XB_XCNT(b.x)], 1u);
    return b;
}
__device__ __forceinline__ void xcd_barrier_complete(unsigned* bar, unsigned x, unsigned& nloc, unsigned& nx) {
    const unsigned G = gridDim.x * gridDim.y * gridDim.z;
    unsigned sum, cnt, mine, sp = 0u;
    for (;;) {
        sum = 0u; cnt = 0u; mine = 0u;
#pragma unroll
        for (unsigned j = 0; j < 16; ++j) { const unsigned c = xb_ld(&bar[XB_XCNT(j)]); sum += c; cnt += (c > 0u) ? 1u : 0u; mine = (j == x) ? c : mine; }
        if (sum == G) break;
        __builtin_amdgcn_s_sleep(1);
        if ((++sp & 255u) == 0u) { if (xb_ld(&bar[XB_TMO])) break; if (sp > XB_SPIN_CAP) { atomicAdd(&bar[XB_TMO], 1u); break; } }
    }
    nloc = mine > 0u ? mine : 1u; nx = cnt > 0u ? cnt : 1u;
}

__device__ __forceinline__ void xcd_barrier(const XcdBarrier& b) {
    asm volatile("s_waitcnt vmcnt(0)" ::: "memory");
    __syncthreads();
    if (threadIdx.x == 0) {
        unsigned* bar = b.bar;
        __builtin_amdgcn_s_waitcnt(0);
        unsigned nloc = b.st[0], nx = b.st[1];
        if (nloc == 0u) { xcd_barrier_complete(bar, b.x, nloc, nx); b.st[0] = nloc; b.st[1] = nx; }
        const unsigned old = xb_add(&bar[XB_XSUB(b.x)], 1u);
        const unsigned gen = old / nloc;
        if (old + 1u == (gen + 1u) * nloc) {
            __builtin_amdgcn_fence(__ATOMIC_RELEASE, "agent");
            asm volatile("s_waitcnt vmcnt(0)" ::: "memory");
            const unsigned og = xb_add(&bar[XB_TOP], 1u);
            const unsigned tg = og / nx;
            if (og + 1u == (tg + 1u) * nx) xb_add(&bar[XB_TOPGEN], 1u);
            else XB_SPIN(xb_ld(&bar[XB_TOPGEN]) == tg, bar);
            __builtin_amdgcn_fence(__ATOMIC_ACQUIRE, "agent");
            xb_add(&bar[XB_XGEN(b.x)], 1u);
            asm volatile("s_waitcnt vmcnt(0)" ::: "memory");
        } else {
            XB_SPIN(xb_ld(&bar[XB_XGEN(b.x)]) == gen, bar);
            __builtin_amdgcn_fence(__ATOMIC_ACQUIRE, "agent");
            asm volatile("s_waitcnt vmcnt(0)" ::: "memory");
        }
    }
    __syncthreads();
}

__device__ __forceinline__ void build_rtab(LAS float* rtab, const float* part, int rowbase, int tid) {
#pragma unroll 1
    for (int i = tid; i < 2048; i += NTHREADS) {
        const f32x4* p = (const f32x4*)(part + (size_t)(rowbase + i) * 32);
        f32x4 v[8];
#pragma unroll
        for (int k = 0; k < 8; ++k) v[k] = p[k];
        float s = 0.f;
#pragma unroll
        for (int k = 0; k < 8; ++k) s += (v[k][0] + v[k][1]) + (v[k][2] + v[k][3]);
        rtab[i] = __builtin_amdgcn_rsqf(s * (1.0f / D) + EPS);
    }
    __syncthreads();
}

typedef const __attribute__((address_space(4))) Args* kargp;
__device__ __forceinline__ kargp kargs() { kargp p = (kargp)__builtin_amdgcn_kernarg_segment_ptr(); asm volatile("" : "+s"(p)); return p; }
__global__ void __launch_bounds__(NTHREADS, 2) fwd_megakernel(Args a_unused) {
    extern __shared__ __attribute__((aligned(16))) unsigned char lds_raw[];
    cg::grid_group grid = cg::this_grid();
    ldsp lds = (ldsp)lds_raw;
    const int tid = threadIdx.x, lane = tid & 63, wave = __builtin_amdgcn_readfirstlane(tid >> 6);
    const int G = gridDim.x, bid = blockIdx.x;
    const int gw = bid * NWAVES + wave, NGW = G * NWAVES, gtid = bid * NTHREADS + tid, NGT = G * NTHREADS;
    unsigned char* ws = kargs()->ws;

#ifndef PROBE_PRO
#define PROBE_PRO 1
#endif
#ifndef PROBE_MIX
#define PROBE_MIX 1
#endif
#ifndef PROBE_FFI
#define PROBE_FFI 1
#endif
    volatile LAS unsigned* bar_st = (volatile LAS unsigned*)(lds + LDS_BYTES - 64);
    if (tid < 2) bar_st[tid] = 0u;
    if (bid == 0) { unsigned* bw = (unsigned*)a_unused.ws; for (int i = tid; i < XCD_BAR_WORDS; i += NTHREADS) bw[i] = 0u; }
    for (int rep = 0; rep < PROBE_PRO; ++rep) prologue(a_unused, lds, gw, NGW, lane, wave);
    prologue_rows(a_unused, gw, NGW, lane, gtid, NGT);
    grid.sync();
    const XcdBarrier xbar = xcd_barrier_post((unsigned*)ws, bar_st);

    for (int step = 0; step < 6; ++step) {
        const int l = step / 3, sub = step % 3;
        ws = kargs()->ws; const unsigned char* wl = ws + WS_W + (size_t)l * WL_SIZE;
        float* partb = (float*)(ws + WS_PART); const float* cs = (const float*)(ws + WS_CS); LAS float* rtab = (LAS float*)(lds + 131072);
        bf16* XB = (bf16*)(ws + WS_XB); bf16* ACT = (bf16*)(ws + WS_ACT); bf16* PB = (bf16*)(ws + WS_P); bf16* MX = (bf16*)(ws + WS_MX);
        const float* part_in = partb + (size_t)step * M * 32; float* part_out = partb + (size_t)(step + 1) * M * 32;
        const bf16* A2; const bf16* B2; int K2; float scale;
        if (sub != 1) {
            pg8::Gemm g{XB, (const bf16*)(wl + (sub == 0 ? WL_F1I : WL_F2I)), M, NFF, D}; pg8::StaticOrder S; S.init(M, NFF, G, bid);
            pg8::Unit u0; int rowbase = 0; if (S.next(0, u0)) rowbase = (u0.pm & ~7) * 256;
            { int tl = threadIdx.x; asm volatile("" : "+v"(tl)); build_rtab(rtab, part_in, rowbase, tl); }
            EpiSwiGLU E{ACT, rtab, rowbase};
            for (int rep = 0; rep < PROBE_FFI; ++rep) pg8::gemm_phase<EpiSwiGLU, pg8::StaticOrder, true, true>(lds, g, S, E);
            xcd_barrier(xbar);
            A2 = ACT; B2 = (const bf16*)(wl + (sub == 0 ? WL_F1O : WL_F2O)); K2 = FF; scale = 0.5f;
        } else {
            {
                pg8::Gemm g{XB, (const bf16*)(wl + WL_IN), M, NIN, D}; pg8::StaticOrder S; S.init(M, NIN, G, bid);
                pg8::Unit u0; int rowbase = 0; if (S.next(0, u0)) rowbase = (u0.pm & ~7) * 256;
                { int tl = threadIdx.x; asm volatile("" : "+v"(tl)); build_rtab(rtab, part_in, rowbase, tl); }
                EpiMixIn E{PB, rtab, rowbase, cs};
                pg8::gemm_phase<EpiMixIn, pg8::StaticOrder, true, true>(lds, g, S, E);
            }
            xcd_barrier(xbar);
            for (int rep = 0; rep < PROBE_MIX; ++rep)
            for (int u = bid; u < 1280; u += G) {
                kargp a = kargs(); int tl = threadIdx.x; asm volatile("" : "+v"(tl));
                if (u < 512) attn_unit(lds, PB, MX, a->attn_sinks + l * 16, u >> 7, (u & 127) >> 2, u & 3, tl);
                else if (u < 1024) conv_unit(lds, PB, MX, a->conv_dw_w + (size_t)l * 31 * 512, a->conv_dw_b + l * 512, a->conv_ln_g + l * 512, a->conv_ln_b + l * 512, u - 512, tl);
                else sgu_unit(lds, PB, MX, a->sgu_ln_g + l * 512, a->sgu_ln_b + l * 512, a->sgu_w + (size_t)l * 8 * 128 * 128, a->sgu_b + l * 8 * 128, (u - 1024) >> 1, (u - 1024) & 1, tl);
            }
            xcd_barrier(xbar);
            A2 = MX; B2 = (const bf16*)(wl + WL_OUT); K2 = D; scale = 1.0f;
        }
        {
            pg8::Gemm g{A2, B2, M, D, K2}; pg8::StaticOrder S; S.init(M, D, G, bid);
            EpiResid E{XB, part_out, scale};
            pg8::gemm_phase<EpiResid, pg8::StaticOrder, true, true>(lds, g, S, E);
        }
        xcd_barrier(xbar);
    }
    {
        kargp a = kargs(); const float* part = (const float*)(a->ws + WS_PART) + (size_t)6 * M * 32; float* outp = a->out; const float* fng = a->final_norm; const bf16* XBf = (const bf16*)(a->ws + WS_XB);
        for (int m = gw; m < M; m += NGW) {
            const float r = __builtin_amdgcn_rsqf(wave_sum(lane < 32 ? part[(size_t)m * 32 + lane] : 0.f) * (1.0f / D) + EPS);
            const v4u* xr = (const v4u*)(XBf + (size_t)m * D) + lane; f32x4* orow = (f32x4*)(outp + (size_t)m * D); const f32x4* gr = (const f32x4*)fng;
#pragma unroll
            for (int j = 0; j < 4; ++j) {
                const v4u b = xr[64 * j]; const int c4 = 2 * (lane + 64 * j);
                const f32x4 x0 = {bflo(b.x), bfhi(b.x), bflo(b.y), bfhi(b.y)}, x1 = {bflo(b.z), bfhi(b.z), bflo(b.w), bfhi(b.w)};
                orow[c4] = x0 * r * gr[c4]; orow[c4 + 1] = x1 * r * gr[c4 + 1];
            }
        }
    }
}

extern "C" void kernel_launch(void* const* d_in, const int* in_sizes, int n_in, void* d_out, int out_size, void* d_ws, size_t ws_size, hipStream_t stream) {
    static int grid_blocks = 0;
    if (grid_blocks == 0) {
        if (n_in != 21 || out_size != M * D || ws_size < WS_END) { fprintf(stderr, "kernel_launch: unexpected shapes (n_in %d out %d ws %zu need %zu)\n", n_in, out_size, ws_size, (size_t)WS_END); grid_blocks = -1; return; }
        int dev = 0, cus = 0, per_cu = 0;
        (void)hipGetDevice(&dev);
        (void)hipDeviceGetAttribute(&cus, hipDeviceAttributeMultiprocessorCount, dev);
        if (hipFuncSetAttribute((const void*)fwd_megakernel, hipFuncAttributeMaxDynamicSharedMemorySize, LDS_BYTES) != hipSuccess) { fprintf(stderr, "kernel_launch: hipFuncSetAttribute failed\n"); grid_blocks = -1; return; }
        if (hipOccupancyMaxActiveBlocksPerMultiprocessor(&per_cu, (const void*)fwd_megakernel, NTHREADS, LDS_BYTES) != hipSuccess || per_cu < 1) { fprintf(stderr, "kernel_launch: occupancy query says %d\n", per_cu); per_cu = 1; (void)hipGetLastError(); }
        grid_blocks = cus * per_cu;
    }
    if (grid_blocks < 0) return;
    Args a{};
    a.x = (const float*)d_in[0]; a.pos = (const int*)d_in[1];
    a.norm_ffn1 = (const float*)d_in[2]; a.ffn1_w_in = (const float*)d_in[3]; a.ffn1_w_out = (const float*)d_in[4]; a.norm_mix = (const float*)d_in[5]; a.w_in = (const float*)d_in[6];
    a.conv_dw_w = (const float*)d_in[7]; a.conv_dw_b = (const float*)d_in[8]; a.conv_ln_g = (const float*)d_in[9]; a.conv_ln_b = (const float*)d_in[10];
    a.sgu_ln_g = (const float*)d_in[11]; a.sgu_ln_b = (const float*)d_in[12]; a.sgu_w = (const float*)d_in[13]; a.sgu_b = (const float*)d_in[14]; a.attn_sinks = (const float*)d_in[15];
    a.w_out = (const float*)d_in[16]; a.norm_ffn2 = (const float*)d_in[17]; a.ffn2_w_in = (const float*)d_in[18]; a.ffn2_w_out = (const float*)d_in[19]; a.final_norm = (const float*)d_in[20];
    a.out = (float*)d_out; a.ws = (unsigned char*)d_ws;
    void* args[] = {&a};
    hipError_t e = hipLaunchCooperativeKernel((const void*)fwd_megakernel, dim3(grid_blocks), dim3(NTHREADS), args, LDS_BYTES, stream);
    if (e != hipSuccess) fprintf(stderr, "kernel_launch: cooperative launch failed: %s (grid %d)\n", hipGetErrorString(e), grid_blocks);
}
```

```cpp
#include <hip/hip_runtime.h>
#include <hip/hip_cooperative_groups.h>
#include <cstdio>
#include <cstdint>
namespace cg = cooperative_groups;
namespace pg8 {
#define PG8_LAS __attribute__((address_space(3)))
typedef unsigned short bf16_t;
typedef short bf16x8 __attribute__((ext_vector_type(8)));
typedef float f32x4 __attribute__((ext_vector_type(4)));
typedef unsigned u32x4 __attribute__((ext_vector_type(4)));
constexpr int BM = 256, BK = 64, HALF = 128, HTB = HALF * BK * 2  , STAGE_BYTES = 8 * HTB, NXCD = 8, WGM = 8;

__host__ __device__ __forceinline__ int lds_byte(int r, int c) { const int st = (r >> 4) * 2 + (c >> 5), rr = r & 15, cc = c & 31, ob = rr * 64 + cc * 2; return st * 1024 + (ob ^ (((ob >> 9) & 1) << 5)); }
__host__ __device__ __forceinline__ void stage_rc(int b, int& R, int& C) { const int st = b / 1024, sb = b % 1024, swz = sb ^ (((sb >> 9) & 1) << 5); R = (st >> 1) * 16 + swz / 64; C = (st & 1) * 32 + (swz % 64) / 2; }
__host__ __device__ __forceinline__ int perm32(int rho) { const int n = rho >> 4, i = rho & 15; return 8 * (i >> 2) + 4 * n + (i & 3); }

struct Unit { int pm, pn; };
struct Gemm { const bf16_t* A; const bf16_t* Bt; int M, N, K; };

struct StaticOrder {
    int nM, nN, nwg, G, c;
    __host__ __device__ void init(int M, int N, int G_, int c_) { nM = M / BM; nN = N / BM; nwg = nM * nN; G = G_; c = c_; }
    __host__ __device__ bool next(int i, Unit& u) const {
        const long L = (long)i * G + c; if (L >= nwg) return false;
        int wgid = (int)L; { const int q = nwg / NXCD, r = nwg % NXCD, xcd = wgid % NXCD, off = wgid / NXCD; wgid = (xcd < r ? xcd * (q + 1) : r * (q + 1) + (xcd - r) * q) + off; }
        const int nig = WGM * nN, gid = wgid / nig, fm = gid * WGM, gsz = (nM - fm) < WGM ? (nM - fm) : WGM;
        u.pm = fm + ((wgid % nig) % gsz); u.pn = (wgid % nig) / gsz; return true;
    }
    __device__ __forceinline__ void a_ready(const Unit&) const {}
    __device__ __forceinline__ void done(const Unit&) const {}
};

__device__ __forceinline__ unsigned cvt_pk_bf16(float lo, float hi) { unsigned r; asm volatile("v_cvt_pk_bf16_f32 %0, %1, %2" : "=v"(r) : "v"(lo), "v"(hi)); return r; }
typedef float f32x2 __attribute__((ext_vector_type(2)));
template <class Epi, class Sched, bool ALIGN_EPI = false, bool SP2 = false>
__device__ __forceinline__ void gemm_phase(PG8_LAS unsigned char* lds, const Gemm g, const Sched& S, const Epi& E) {
    int tid_ = threadIdx.x; asm volatile("" : "+v"(tid_));
    const int tid = tid_, wid = __builtin_amdgcn_readfirstlane(tid >> 6), lane = tid & 63, wr = wid >> 2, wc = wid & 3, fr = lane & 15, fq = lane >> 4;
    const int K = g.K, nt = K / BK;
    unsigned voffA[2], voffB[2];
#pragma unroll
    for (int i = 0; i < 2; ++i) { int R, C; stage_rc(tid * 16 + i * 8192, R, C); const int Rb = Epi::PERM ? ((R & ~31) + perm32(R & 31)) : R;
        voffA[i] = (unsigned)(R * K + C) * 2u; voffB[i] = (unsigned)(Rb * K + C) * 2u; }
    const size_t kstep = (size_t)(BK * 2);
    const size_t hstep = (size_t)HALF * K * 2;
    const size_t tstep = 2 * hstep;
    const unsigned ldsw = (unsigned)wid * 1024u;
    const int aoff = lds_byte(wr * 64 + fr, fq * 8), boff = lds_byte(wc * 32 + fr, fq * 8);
#define PG8_SA(b, h) (((b) * 2 + (h)) * HTB)
#define PG8_SB(b, h) ((4 + (b) * 2 + (h)) * HTB)
#define PG8_STAGE(bufoff, gbase, voff) do { _Pragma("unroll") for (int _i = 0; _i < 2; ++_i) \
        __builtin_amdgcn_global_load_lds((const unsigned*)((const char*)(gbase) + (voff)[_i]), (PG8_LAS unsigned*)(lds + (bufoff) + ldsw + _i * 8192), 16, 0, 0); } while (0)
#define PG8_LDA(dst, b, h) do { _Pragma("unroll") for (int m = 0; m < 4; ++m) _Pragma("unroll") for (int k = 0; k < 2; ++k) dst[m][k] = *(const PG8_LAS bf16x8*)(lds + PG8_SA(b, h) + aoff + m * 2048 + k * 1024); } while (0)
#define PG8_LDB(dst, b, h) do { _Pragma("unroll") for (int n = 0; n < 2; ++n) _Pragma("unroll") for (int k = 0; k < 2; ++k) dst[n][k] = *(const PG8_LAS bf16x8*)(lds + PG8_SB(b, h) + boff + n * 2048 + k * 1024); } while (0)
#define PG8_MMA(ai, bj, At, Bt) do { __builtin_amdgcn_s_setprio(1); _Pragma("unroll") for (int m = 0; m < 4; ++m) _Pragma("unroll") for (int n = 0; n < 2; ++n) _Pragma("unroll") for (int k = 0; k < 2; ++k) \
        acc[ai][bj][m][n] = __builtin_amdgcn_mfma_f32_16x16x32_bf16(Bt[n][k], At[m][k], acc[ai][bj][m][n], 0, 0, 0); __builtin_amdgcn_s_setprio(0); } while (0)
#define PG8_WAIT_V(n) asm volatile("s_waitcnt vmcnt(" #n ")" ::: "memory")
#define PG8_WAIT_L(n) asm volatile("s_waitcnt lgkmcnt(" #n ")" ::: "memory")
#define PG8_BAR __builtin_amdgcn_s_barrier()
#define PG8_SCHED __builtin_amdgcn_sched_barrier(0)
    Unit cur, nxt; int ui = 0;
    if (!S.next(0, cur)) return;
    f32x4 acc[2][2][4][2];
#pragma unroll
    for (int a = 0; a < 2; ++a)
#pragma unroll
        for (int b = 0; b < 2; ++b)
#pragma unroll
            for (int m = 0; m < 4; ++m)
#pragma unroll
                for (int n = 0; n < 2; ++n) acc[a][b][m][n] = (f32x4){0.f, 0.f, 0.f, 0.f};
    bf16x8 At[4][2], B0[2][2], B1[2][2];
    const char* cA = (const char*)g.A + (size_t)cur.pm * tstep; const char* cB = (const char*)g.Bt + (size_t)cur.pn * tstep;
    S.a_ready(cur);
    if constexpr (SP2) {
        PG8_STAGE(PG8_SB(0, 0), cB, voffB); PG8_STAGE(PG8_SB(0, 1), cB + hstep, voffB); PG8_STAGE(PG8_SA(0, 0), cA, voffA); PG8_STAGE(PG8_SA(0, 1), cA + hstep, voffA);
        if (wr == 1) PG8_BAR;
        PG8_WAIT_V(2); PG8_BAR;
        PG8_STAGE(PG8_SB(1, 0), cB + kstep, voffB); PG8_STAGE(PG8_SA(1, 0), cA + kstep, voffA); PG8_STAGE(PG8_SB(1, 1), cB + hstep + kstep, voffB);
        PG8_WAIT_V(6); PG8_BAR;
    } else {
        PG8_STAGE(PG8_SB(0, 0), cB, voffB); PG8_STAGE(PG8_SA(0, 0), cA, voffA); PG8_STAGE(PG8_SB(0, 1), cB + hstep, voffB); PG8_STAGE(PG8_SA(0, 1), cA + hstep, voffA);
        if (wr == 1) PG8_BAR;
        PG8_WAIT_V(4); PG8_BAR;
        PG8_STAGE(PG8_SB(1, 0), cB + kstep, voffB); PG8_STAGE(PG8_SA(1, 0), cA + kstep, voffA); PG8_STAGE(PG8_SB(1, 1), cB + hstep + kstep, voffB);
        PG8_WAIT_V(6); PG8_BAR;
    }
    for (;;) {
        const bool has_next = S.next(ui + 1, nxt);
        const char* nA = has_next ? (const char*)g.A + (size_t)nxt.pm * tstep : cA; const char* nB = has_next ? (const char*)g.Bt + (size_t)nxt.pn * tstep : cB;
        for (int t = 0; t < nt; t += 2) {
            const bool last = (t == nt - 2);
            const char* a1 = cA + (size_t)(t + 1) * kstep;
            const char* a2 = last ? nA : cA + (size_t)(t + 2) * kstep; const char* b2 = last ? nB : cB + (size_t)(t + 2) * kstep;
            const char* a3 = a2 + kstep; const char* b3 = b2 + kstep;
            if (last && has_next) S.a_ready(nxt);
            if constexpr (SP2) {
            PG8_LDB(B0, 0, 0); PG8_LDB(B1, 0, 1); PG8_SCHED; PG8_LDA(At, 0, 0); PG8_STAGE(PG8_SA(1, 1), a1 + hstep, voffA);
            PG8_WAIT_V(8); PG8_WAIT_L(0); PG8_BAR; PG8_MMA(0, 0, At, B0); PG8_MMA(0, 1, At, B1); PG8_BAR; PG8_SCHED;
            PG8_LDA(At, 0, 1); PG8_STAGE(PG8_SB(0, 0), b2, voffB); PG8_STAGE(PG8_SB(0, 1), b2 + hstep, voffB); PG8_STAGE(PG8_SA(0, 0), a2, voffA);
            PG8_WAIT_V(8); PG8_WAIT_L(0); PG8_BAR; PG8_MMA(1, 0, At, B0); PG8_MMA(1, 1, At, B1); PG8_BAR; PG8_SCHED;
            PG8_LDB(B0, 1, 0); PG8_LDB(B1, 1, 1); PG8_SCHED; PG8_LDA(At, 1, 0); PG8_STAGE(PG8_SA(0, 1), a2 + hstep, voffA);
            PG8_WAIT_V(8); PG8_WAIT_L(0); PG8_BAR; PG8_MMA(0, 0, At, B0); PG8_MMA(0, 1, At, B1); PG8_BAR; PG8_SCHED;
            PG8_LDA(At, 1, 1); PG8_STAGE(PG8_SB(1, 0), b3, voffB); PG8_STAGE(PG8_SB(1, 1), b3 + hstep, voffB); PG8_STAGE(PG8_SA(1, 0), a3, voffA);
            PG8_WAIT_V(8); PG8_WAIT_L(0); PG8_BAR; PG8_MMA(1, 0, At, B0); PG8_MMA(1, 1, At, B1); PG8_BAR; PG8_SCHED;
            } else {
            PG8_LDB(B0, 0, 0); PG8_SCHED; PG8_LDA(At, 0, 0); PG8_STAGE(PG8_SA(1, 1), a1 + hstep, voffA);
            PG8_WAIT_L(8); PG8_BAR; PG8_WAIT_L(0); PG8_MMA(0, 0, At, B0); PG8_BAR; PG8_SCHED;
            PG8_LDB(B1, 0, 1); PG8_STAGE(PG8_SB(0, 0), b2, voffB);
            PG8_BAR; PG8_WAIT_L(0); PG8_MMA(0, 1, At, B1); PG8_BAR;
            PG8_LDA(At, 0, 1); PG8_STAGE(PG8_SA(0, 0), a2, voffA);
            PG8_BAR; PG8_WAIT_L(0); PG8_MMA(1, 0, At, B0); PG8_BAR; PG8_SCHED;
            PG8_STAGE(PG8_SB(0, 1), b2 + hstep, voffB);
            PG8_WAIT_V(6); PG8_BAR; PG8_MMA(1, 1, At, B1); PG8_BAR;
            PG8_LDB(B0, 1, 0); PG8_SCHED; PG8_LDA(At, 1, 0); PG8_STAGE(PG8_SA(0, 1), a2 + hstep, voffA);
            PG8_WAIT_L(8); PG8_BAR; PG8_WAIT_L(0); PG8_MMA(0, 0, At, B0); PG8_BAR; PG8_SCHED;
            PG8_LDB(B1, 1, 1); PG8_STAGE(PG8_SB(1, 0), b3, voffB);
            PG8_BAR; PG8_WAIT_L(0); PG8_MMA(0, 1, At, B1); PG8_BAR;
            PG8_LDA(At, 1, 1); PG8_STAGE(PG8_SA(1, 0), a3, voffA);
            PG8_BAR; PG8_WAIT_L(0); PG8_MMA(1, 0, At, B0); PG8_BAR; PG8_SCHED;
            PG8_STAGE(PG8_SB(1, 1), b3 + hstep, voffB);
            PG8_WAIT_V(6); PG8_BAR; PG8_MMA(1, 1, At, B1); PG8_BAR;
            }
        }
        if constexpr (ALIGN_EPI) { if (wr == 0) PG8_BAR; }
        if constexpr (!Epi::AFTER_DRAIN) { E(acc, cur, wr, wc, fr, fq); S.done(cur); }
        if (!has_next) break;
#pragma unroll
        for (int a = 0; a < 2; ++a)
#pragma unroll
            for (int b = 0; b < 2; ++b)
#pragma unroll
                for (int m = 0; m < 4; ++m)
#pragma unroll
                    for (int n = 0; n < 2; ++n) acc[a][b][m][n] = (f32x4){0.f, 0.f, 0.f, 0.f};
        cur = nxt; cA = nA; cB = nB; ++ui;
        if constexpr (ALIGN_EPI) { if (wr == 1) PG8_BAR; }
    }
    PG8_WAIT_V(0);
    if constexpr (!ALIGN_EPI) { if (wr == 0) PG8_BAR; }
    PG8_BAR;
    if constexpr (Epi::AFTER_DRAIN) { E.fused(acc, cur, wr, wc, fr, fq, lds, wid, lane); S.done(cur); }
#undef PG8_SA
#undef PG8_SB
#undef PG8_STAGE
#undef PG8_LDA
#undef PG8_LDB
#undef PG8_MMA
#undef PG8_WAIT_V
#undef PG8_WAIT_L
#undef PG8_BAR
#undef PG8_SCHED
}
}

#define LAS __attribute__((address_space(3)))
typedef unsigned short bf16;
typedef unsigned v4u __attribute__((ext_vector_type(4)));
typedef unsigned v2u __attribute__((ext_vector_type(2)));
typedef float f32x4 __attribute__((ext_vector_type(4)));
typedef short bf16x8 __attribute__((ext_vector_type(8)));
typedef LAS unsigned char* ldsp;

constexpr int M = 16384, D = 2048, FF = 5632, NFF = 2 * FF, NIN = 3584, PW = 3072, SEQ = 4096;
constexpr float EPS = 1e-5f, LOG2E = 1.4426950408889634f;
constexpr int NTHREADS = 512, NWAVES = 8;
constexpr int LDS_BYTES = 147456;

constexpr size_t MiB = 1u << 20;
constexpr size_t WS_SS = 1 * MiB;
constexpr size_t WS_CS = 2 * MiB;
constexpr size_t WS_W = 4 * MiB;
constexpr size_t WL_F1I = 0, WL_F1O = 44 * MiB, WL_IN = 66 * MiB, WL_OUT = 80 * MiB, WL_F2I = 88 * MiB, WL_F2O = 132 * MiB, WL_SIZE = 154 * MiB;
constexpr size_t WS_XB = WS_W + 2 * WL_SIZE;
constexpr size_t WS_ACT = WS_XB + 64 * MiB;
constexpr size_t WS_P = WS_ACT, WS_MX = WS_ACT + 96 * MiB;
constexpr size_t WS_PART = WS_ACT + 176 * MiB;
constexpr size_t WS_END = WS_PART + 16 * MiB;

__device__ __forceinline__ float bflo(unsigned u) { return __uint_as_float(u << 16); }
__device__ __forceinline__ float bfhi(unsigned u) { return __uint_as_float(u & 0xffff0000u); }
__device__ __forceinline__ unsigned pk(float lo, float hi) { return pg8::cvt_pk_bf16(lo, hi); }
__device__ __forceinline__ float wave_sum(float v) {
    v += __builtin_bit_cast(float, __builtin_amdgcn_update_dpp(0, __builtin_bit_cast(int, v), 0x111, 0xf, 0xf, true));
    v += __builtin_bit_cast(float, __builtin_amdgcn_update_dpp(0, __builtin_bit_cast(int, v), 0x112, 0xf, 0xf, true));
    v += __builtin_bit_cast(float, __builtin_amdgcn_update_dpp(0, __builtin_bit_cast(int, v), 0x114, 0xf, 0xf, true));
    v += __builtin_bit_cast(float, __builtin_amdgcn_update_dpp(0, __builtin_bit_cast(int, v), 0x118, 0xf, 0xf, true));
    v += __builtin_bit_cast(float, __builtin_amdgcn_update_dpp(0, __builtin_bit_cast(int, v), 0x142, 0xa, 0xf, false));
    v += __builtin_bit_cast(float, __builtin_amdgcn_update_dpp(0, __builtin_bit_cast(int, v), 0x143, 0xc, 0xf, false));
    return __builtin_bit_cast(float, __builtin_amdgcn_readlane(__builtin_bit_cast(int, v), 63));
}
__device__ __forceinline__ float fast_sigmoid(float x) { return __builtin_amdgcn_rcpf(1.0f + __builtin_amdgcn_exp2f(-x * LOG2E)); }

struct EpiSwiGLU {
    static constexpr bool PERM = true, AFTER_DRAIN = false;
    bf16* O; const LAS float* rtab; int rowbase;
    __device__ __forceinline__ void operator()(const f32x4 (&acc)[2][2][4][2], const pg8::Unit& u, int wr, int wc, int fr, int fq) const {
        const int row0 = u.pm * 256 + wr * 64 + fr, col0 = u.pn * 128 + wc * 32 + 8 * fq;
        float rr[8];
#pragma unroll
        for (int k = 0; k < 8; ++k) rr[k] = rtab[(row0 + (k >> 2) * 128 + (k & 3) * 16 - rowbase) & 2047];
#pragma unroll
        for (int ai = 0; ai < 2; ++ai)
#pragma unroll
            for (int m = 0; m < 4; ++m) {
                const int row = row0 + ai * 128 + m * 16;
                const float r = rr[ai * 4 + m], nrl = -r * LOG2E, r2 = r * r;
                typedef float f2 __attribute__((ext_vector_type(2)));
                f2 e[4], gu[4];
#pragma unroll
                for (int k = 0; k < 4; ++k) {
                    const f2 g = {acc[ai][0][m][k >> 1][2 * (k & 1)], acc[ai][0][m][k >> 1][2 * (k & 1) + 1]}, uu = {acc[ai][1][m][k >> 1][2 * (k & 1)], acc[ai][1][m][k >> 1][2 * (k & 1) + 1]};
                    const f2 t = g * nrl; gu[k] = (g * uu) * r2;
                    e[k].x = __builtin_amdgcn_exp2f(t.x); e[k].y = __builtin_amdgcn_exp2f(t.y);
                }
#pragma unroll
                for (int k = 0; k < 4; ++k) { e[k] = e[k] + 1.0f; e[k].x = __builtin_amdgcn_rcpf(e[k].x); e[k].y = __builtin_amdgcn_rcpf(e[k].y); gu[k] = gu[k] * e[k]; }
                v4u w; w.x = pk(gu[0].x, gu[0].y); w.y = pk(gu[1].x, gu[1].y); w.z = pk(gu[2].x, gu[2].y); w.w = pk(gu[3].x, gu[3].y);
                *(v4u*)(O + (size_t)row * FF + col0) = w;
            }
    }
};
struct EpiResid {
    static constexpr bool PERM = true, AFTER_DRAIN = false;
    bf16* xb; float* part_out; float scale;
    __device__ __forceinline__ void operator()(const f32x4 (&acc)[2][2][4][2], const pg8::Unit& u, int wr, int wc, int fr, int fq) const {
        const int row0 = u.pm * 256 + wr * 64 + fr, col0 = u.pn * 256 + wc * 32 + 8 * fq;
#pragma unroll
        for (int ai = 0; ai < 2; ++ai) {
            v4u bs[4][2];
#pragma unroll
            for (int m = 0; m < 4; ++m)
#pragma unroll
                for (int bj = 0; bj < 2; ++bj) bs[m][bj] = *(const v4u*)(xb + (size_t)(row0 + ai * 128 + m * 16) * D + col0 + bj * 128);
#pragma unroll
            for (int m = 0; m < 4; ++m) {
                const int row = row0 + ai * 128 + m * 16; float sq = 0.f;
#pragma unroll
                for (int bj = 0; bj < 2; ++bj) {
                    const size_t off = (size_t)row * D + col0 + bj * 128;
                    const v4u b = bs[m][bj];
                    const f32x4 b0 = {bflo(b.x), bfhi(b.x), bflo(b.y), bfhi(b.y)}, b1 = {bflo(b.z), bfhi(b.z), bflo(b.w), bfhi(b.w)};
                    const f32x4 x0 = b0 + acc[ai][bj][m][0] * scale, x1 = b1 + acc[ai][bj][m][1] * scale;
                    v4u w; w.x = pk(x0[0], x0[1]); w.y = pk(x0[2], x0[3]); w.z = pk(x1[0], x1[1]); w.w = pk(x1[2], x1[3]);
                    *(v4u*)(xb + off) = w;
                    sq += (x0[0] * x0[0] + x0[1] * x0[1]) + (x0[2] * x0[2] + x0[3] * x0[3]) + (x1[0] * x1[0] + x1[1] * x1[1]) + (x1[2] * x1[2] + x1[3] * x1[3]);
                }
                sq += __shfl_xor(sq, 16); sq += __shfl_xor(sq, 32);
                if (fq == 0) part_out[(size_t)row * 32 + u.pn * 4 + wc] = sq;
            }
            asm volatile("" ::: "memory");
        }
    }
};
struct EpiMixIn {
    static constexpr bool PERM = true, AFTER_DRAIN = false;
    bf16* P; const LAS float* rtab; int rowbase; const float* cs;
    __device__ __forceinline__ void operator()(const f32x4 (&acc)[2][2][4][2], const pg8::Unit& u, int wr, int wc, int fr, int fq) const {
        const int row0 = u.pm * 256 + wr * 64 + fr, pn = u.pn, lc = wc * 32 + 8 * fq;
        float rr[8];
#pragma unroll
        for (int k = 0; k < 8; ++k) rr[k] = rtab[(row0 + (k >> 2) * 128 + (k & 3) * 16 - rowbase) & 2047];
#pragma unroll
        for (int ai = 0; ai < 2; ++ai)
#pragma unroll
            for (int m = 0; m < 4; ++m) {
                const int row = row0 + ai * 128 + m * 16;
                const float r = rr[ai * 4 + m];
                f32x4 a0 = acc[ai][0][m][0] * r, a1 = acc[ai][0][m][1] * r, b0 = acc[ai][1][m][0] * r, b1 = acc[ai][1][m][1] * r;
                bf16* prow = P + (size_t)row * PW;
                if (pn >= 6 && pn < 10) {
                    float o[8];
#pragma unroll
                    for (int i = 0; i < 4; ++i) { o[i] = a0[i] * fast_sigmoid(b0[i]); o[4 + i] = a1[i] * fast_sigmoid(b1[i]); }
                    v4u w; w.x = pk(o[0], o[1]); w.y = pk(o[2], o[3]); w.z = pk(o[4], o[5]); w.w = pk(o[6], o[7]);
                    *(v4u*)(prow + 1536 + 128 * (pn - 6) + lc) = w;
                } else {
                    if (pn < 5) {
                        if ((wc & 1) == 0) {
                            f32x4 pa0, pa1, pb0, pb1;
#pragma unroll
                            for (int i = 0; i < 4; ++i) { pa0[i] = __shfl_xor(a0[i], 16); pa1[i] = __shfl_xor(a1[i], 16); pb0[i] = __shfl_xor(b0[i], 16); pb1[i] = __shfl_xor(b1[i], 16); }
                            if (fq < 2) {
                                const float* c = cs + (size_t)row * 16;
                                const f32x4 c0 = *(const f32x4*)c, c1 = *(const f32x4*)(c + 4); f32x4 s0 = *(const f32x4*)(c + 8), s1 = *(const f32x4*)(c + 12);
                                if (fq == 0) { s0 = -s0; s1 = -s1; }
                                a0 = a0 * c0 + pa0 * s0; a1 = a1 * c1 + pa1 * s1; b0 = b0 * c0 + pb0 * s0; b1 = b1 * c1 + pb1 * s1;
                            }
                        }
                        if (pn < 4) { a0 = a0 * 0.125f; a1 = a1 * 0.125f; b0 = b0 * 0.125f; b1 = b1 * 0.125f; }
                    }
                    const int cb = (pn <= 5 ? 256 * pn : 256 * pn - 512) + lc;
                    v4u w; w.x = pk(a0[0], a0[1]); w.y = pk(a0[2], a0[3]); w.z = pk(a1[0], a1[1]); w.w = pk(a1[2], a1[3]);
                    *(v4u*)(prow + cb) = w;
                    v4u z; z.x = pk(b0[0], b0[1]); z.y = pk(b0[2], b0[3]); z.z = pk(b1[0], b1[1]); z.w = pk(b1[2], b1[3]);
                    *(v4u*)(prow + cb + 128) = z;
                }
                if (m & 1) asm volatile("" ::: "memory");
            }
    }
};

__device__ __forceinline__ void transpose_item(const float* W, int K, int N, const float* g, bf16* WT, int k0, int n0, int sn0, LAS unsigned* scr, int lane) {
    const int c4 = lane & 31, ph = lane >> 5;
    const float* src = W + (size_t)(k0 + 2 * ph) * N + sn0 + 4 * c4;
    f32x4 ra[16], rb[16];
#pragma unroll
    for (int i = 0; i < 16; ++i) { ra[i] = *(const f32x4*)(src + (size_t)(4 * i) * N); rb[i] = *(const f32x4*)(src + (size_t)(4 * i + 1) * N); }
#pragma unroll
    for (int i = 0; i < 16; ++i) {
        const int p = ph + 2 * i;
        float ga = 1.f, gb = 1.f; if (g) { ga = g[k0 + 2 * p]; gb = g[k0 + 2 * p + 1]; }
        LAS unsigned* d = scr + p * 129 + c4;
        d[0] = pk(ra[i][0] * ga, rb[i][0] * gb); d[32] = pk(ra[i][1] * ga, rb[i][1] * gb); d[64] = pk(ra[i][2] * ga, rb[i][2] * gb); d[96] = pk(ra[i][3] * ga, rb[i][3] * gb);
    }
    asm volatile("s_waitcnt lgkmcnt(0)" ::: "memory");
    const int c = lane & 7, q = lane >> 3;
#pragma unroll
    for (int j = 0; j < 16; ++j) {
        const int n = 4 * ((q & 3) + 4 * (j >> 1)) + ((q >> 2) + 2 * (j & 1));
        const LAS unsigned* sp = scr + (4 * c) * 129 + (n & 3) * 32 + (n >> 2);
        v4u o; o.x = sp[0]; o.y = sp[129]; o.z = sp[258]; o.w = sp[387];
        *(v4u*)(WT + (size_t)(n0 + n) * K + k0 + 8 * c) = o;
    }
    asm volatile("s_waitcnt lgkmcnt(0)" ::: "memory");
}
__device__ __forceinline__ int src_col(int mode, int n0) {
    if (mode == 1) return ((n0 >> 7) & 1) * FF + 128 * (n0 >> 8) + (n0 & 127);
    if (mode == 2) { const int pn = n0 >> 8; if (pn >= 6 && pn < 10) return 1536 + 512 * ((n0 >> 7) & 1) + 128 * (pn - 6) + (n0 & 127); }
    return n0;
}
__device__ __forceinline__ void convert_matrix(const float* W, int K, int N, const float* g, bf16* WT, int mode, int item, LAS unsigned* scr, int lane) {
    const int nblk = N / 128, kb = item / nblk, nb = item % nblk;
    transpose_item(W, K, N, g, WT, 64 * kb, 128 * nb, src_col(mode, 128 * nb), scr, lane);
}

struct Args {
    const float* x; const int* pos;
    const float *norm_ffn1, *ffn1_w_in, *ffn1_w_out, *norm_mix, *w_in, *conv_dw_w, *conv_dw_b, *conv_ln_g, *conv_ln_b, *sgu_ln_g, *sgu_ln_b, *sgu_w, *sgu_b, *attn_sinks, *w_out,
        *norm_ffn2, *ffn2_w_in, *ffn2_w_out, *final_norm;
    float* out; unsigned char* ws;
};

__device__ __forceinline__ void prologue(const Args& a, ldsp lds, int gw, int NGW, int lane, int wave) {
    LAS unsigned* scr = (LAS unsigned*)(lds + wave * 16640);
    constexpr int I_FI = (D / 64) * (NFF / 128), I_FO = (FF / 64) * (D / 128), I_IN = (D / 64) * (NIN / 128), I_OUT = (D / 64) * (D / 128);
    constexpr int I_LAYER = 2 * I_FI + 2 * I_FO + I_IN + I_OUT;
    for (int it = gw; it < 2 * I_LAYER; it += NGW) {
        const int l = it / I_LAYER; int r = it % I_LAYER;
        unsigned char* wl = a.ws + WS_W + (size_t)l * WL_SIZE;
        if (r < I_FI) { convert_matrix(a.ffn1_w_in + (size_t)l * D * NFF, D, NFF, a.norm_ffn1 + l * D, (bf16*)(wl + WL_F1I), 1, r, scr, lane); continue; } r -= I_FI;
        if (r < I_FI) { convert_matrix(a.ffn2_w_in + (size_t)l * D * NFF, D, NFF, a.norm_ffn2 + l * D, (bf16*)(wl + WL_F2I), 1, r, scr, lane); continue; } r -= I_FI;
        if (r < I_IN) { convert_matrix(a.w_in + (size_t)l * D * NIN, D, NIN, a.norm_mix + l * D, (bf16*)(wl + WL_IN), 2, r, scr, lane); continue; } r -= I_IN;
        if (r < I_FO) { convert_matrix(a.ffn1_w_out + (size_t)l * FF * D, FF, D, nullptr, (bf16*)(wl + WL_F1O), 0, r, scr, lane); continue; } r -= I_FO;
        if (r < I_FO) { convert_matrix(a.ffn2_w_out + (size_t)l * FF * D, FF, D, nullptr, (bf16*)(wl + WL_F2O), 0, r, scr, lane); continue; } r -= I_FO;
        convert_matrix(a.w_out + (size_t)l * D * D, D, D, nullptr, (bf16*)(wl + WL_OUT), 0, r, scr, lane);
    }
}

__device__ __forceinline__ void prologue_rows(const Args& a, int gw, int NGW, int lane, int gtid, int NGT) {
    bf16* XB = (bf16*)(a.ws + WS_XB); float* part0 = (float*)(a.ws + WS_PART);
    for (int m = gw; m < M; m += NGW) {
        const f32x4* xr = (const f32x4*)(a.x + (size_t)m * D) + lane; v2u* o8 = (v2u*)(XB + (size_t)m * D) + lane; float s = 0.f;
#pragma unroll
        for (int j = 0; j < 8; ++j) { const f32x4 v = xr[64 * j]; s += (v[0] * v[0] + v[1] * v[1]) + (v[2] * v[2] + v[3] * v[3]); v2u w; w.x = pk(v[0], v[1]); w.y = pk(v[2], v[3]); o8[64 * j] = w; }
        s = wave_sum(s);
        if (lane < 32) part0[(size_t)m * 32 + lane] = (lane == 0) ? s : 0.f;
    }
    float* cs = (float*)(a.ws + WS_CS);
    for (int i = gtid; i < M * 8; i += NGT) {
        const int m = i >> 3, f = i & 7;
        const float invf[8] = {1.0f, 0.193922758102417f, 0.03760603070259094f, 0.00729266507551074f, 0.001414213445968926f, 0.00027424818836152554f, 5.318296462064609e-05f, 1.0313385246263351e-05f};
        float fr_ = invf[0];
#pragma unroll
        for (int k = 1; k < 8; ++k) fr_ = (f == k) ? invf[k] : fr_;
        const float ang = (float)a.pos[m] * fr_;
        double t = (double)ang * 0.15915494309189533577; t -= __builtin_rint(t);
        const float tf = (float)t;
        cs[(size_t)m * 16 + f] = __builtin_amdgcn_cosf(tf); cs[(size_t)m * 16 + 8 + f] = __builtin_amdgcn_sinf(tf);
    }
}

#define MFMA16(a, b, c) __builtin_amdgcn_mfma_f32_16x16x32_bf16(a, b, c, 0, 0, 0)

__device__ __forceinline__ void attn_unit(ldsp lds, const bf16* P, bf16* MX, const float* sinks, int b, int n, int g, int tid) {
    const int lane = tid & 63, wid = tid >> 6, fr = lane & 15, fq = lane >> 4;
    ldsp Kl = lds; ldsp Vl = lds + 36864;
    const int tok0 = b * SEQ + n * 128;
    const int hq = 4 * g + (wid >> 1), half = wid & 1;
    v4u kvr[4], vvr[4];
#pragma unroll
    for (int i = 0; i < 4; ++i) {
        const int p = tid + 512 * i, key = p >> 3, ch = p & 7;
        kvr[i] = (v4u){0u, 0u, 0u, 0u}; vvr[i] = (v4u){0u, 0u, 0u, 0u};
        if (n > 0 || key >= 128) { const bf16* src = P + (size_t)(tok0 - 128 + key) * PW + 64 * g + 8 * ch; kvr[i] = *(const v4u*)(src + 1024); vvr[i] = *(const v4u*)(src + 1280); }
    }
    const bf16* qbase = P + (size_t)(tok0 + 64 * half + fr) * PW + 64 * hq + 8 * fq;
    bf16x8 qn0 = *(const bf16x8*)qbase, qn1 = *(const bf16x8*)(qbase + 32);
    const float sink = sinks[hq];
#pragma unroll
    for (int i = 0; i < 4; ++i) {
        const int p = tid + 512 * i, key = p >> 3, ch = p & 7;
        *(LAS v4u*)(Kl + key * 144 + ch * 16) = kvr[i];
#pragma unroll
        for (int j = 0; j < 8; ++j) { const unsigned e = (vvr[i][j >> 1] >> (16 * (j & 1))) & 0xffffu; *(LAS unsigned short*)(Vl + (8 * ch + j) * 528 + key * 2) = (unsigned short)e; }
    }
    __syncthreads();
#pragma unroll 1
    for (int mt = 0; mt < 4; ++mt) {
        const int mp = 4 * half + mt;
        const bf16x8 q0 = qn0, q1 = qn1;
        { const bf16* qnx = qbase + (size_t)(16 * (mt < 3 ? mt + 1 : 3)) * PW; qn0 = *(const bf16x8*)qnx; qn1 = *(const bf16x8*)(qnx + 32); }
        f32x4 s[9];
#pragma unroll
        for (int kt = 0; kt < 9; ++kt) {
            ldsp kp = Kl + (16 * (mp + kt) + fr) * 144 + fq * 16;
            const bf16x8 k0 = *(const LAS bf16x8*)kp, k1 = *(const LAS bf16x8*)(kp + 64);
            f32x4 z = {0.f, 0.f, 0.f, 0.f};
            z = MFMA16(k0, q0, z); z = MFMA16(k1, q1, z); s[kt] = z;
        }
#pragma unroll
        for (int i = 0; i < 4; ++i) { if (!(4 * fq + i > fr)) s[0][i] = -1e30f; if (!(4 * fq + i <= fr)) s[8][i] = -1e30f; }
        if (n == 0) {
#pragma unroll
            for (int kt = 0; kt < 8; ++kt) if (mp + kt < 8) s[kt] = (f32x4){-1e30f, -1e30f, -1e30f, -1e30f};
        }
        float mx = sink;
#pragma unroll
        for (int kt = 0; kt < 9; ++kt) mx = fmaxf(mx, fmaxf(fmaxf(s[kt][0], s[kt][1]), fmaxf(s[kt][2], s[kt][3])));
        mx = fmaxf(mx, __shfl_xor(mx, 16)); mx = fmaxf(mx, __shfl_xor(mx, 32));
        float sum = 0.f; const float mxl = mx * LOG2E;
#pragma unroll
        for (int kt = 0; kt < 9; ++kt)
#pragma unroll
            for (int i = 0; i < 4; ++i) { const float p = __builtin_amdgcn_exp2f(s[kt][i] * LOG2E - mxl); s[kt][i] = p; sum += p; }
        sum += __shfl_xor(sum, 16); sum += __shfl_xor(sum, 32);
        sum += __builtin_amdgcn_exp2f(sink * LOG2E - mxl);
        const float inv = 1.0f / sum;
        f32x4 o[4];
#pragma unroll
        for (int nd = 0; nd < 4; ++nd) o[nd] = (f32x4){0.f, 0.f, 0.f, 0.f};
#pragma unroll
        for (int sp = 0; sp < 5; ++sp) {
            const int tA = mp + 2 * sp, tB = (sp < 4) ? tA + 1 : tA;
            v4u pw; pw.x = pk(s[2 * sp][0], s[2 * sp][1]); pw.y = pk(s[2 * sp][2], s[2 * sp][3]);
            const int iB = (sp < 4) ? 2 * sp + 1 : 8;
            if (sp < 4) { pw.z = pk(s[iB][0], s[iB][1]); pw.w = pk(s[iB][2], s[iB][3]); } else { pw.z = 0u; pw.w = 0u; }
            const bf16x8 pf = __builtin_bit_cast(bf16x8, pw);
#pragma unroll
            for (int nd = 0; nd < 4; ++nd) {
                ldsp vr = Vl + (16 * nd + fr) * 528 + 8 * fq;
                v4u vw; const v2u va = *(const LAS v2u*)(vr + 32 * tA), vb = *(const LAS v2u*)(vr + 32 * tB);
                vw.x = va.x; vw.y = va.y; vw.z = vb.x; vw.w = vb.y;
                o[nd] = MFMA16(__builtin_bit_cast(bf16x8, vw), pf, o[nd]);
            }
        }
        bf16* orow = MX + (size_t)(tok0 + 16 * mp + fr) * D + 64 * hq + 4 * fq;
#pragma unroll
        for (int nd = 0; nd < 4; ++nd) { v2u w; w.x = pk(o[nd][0] * inv, o[nd][1] * inv); w.y = pk(o[nd][2] * inv, o[nd][3] * inv); *(v2u*)(orow + 16 * nd) = w; }
    }
    __syncthreads();
}

typedef float f32x2 __attribute__((ext_vector_type(2)));
__device__ __forceinline__ void conv_unit(ldsp lds, const bf16* P, bf16* MX, const float* dw_w, const float* dw_b, const float* ln_g, const float* ln_b, int cu, int tid) {
    const int lane = tid & 63, wid = tid >> 6;
    const int tok0 = 32 * cu, s0 = tok0 & (SEQ - 1);
    ldsp Wl = lds + 65536;
    v4u st[8]; f32x4 sw[8];
#pragma unroll
    for (int i = 0; i < 8; ++i) {
        const int p = tid + NTHREADS * i, r = p >> 6, c = p & 63; st[i] = (v4u){0u, 0u, 0u, 0u};
        if (p < 3968 && s0 - 30 + r >= 0) st[i] = *(const v4u*)(P + (size_t)(tok0 - 30 + r) * PW + 1536 + 8 * c);
        sw[i] = (f32x4){0.f, 0.f, 0.f, 0.f};
        if (p < 3968) sw[i] = *(const f32x4*)(dw_w + 4 * p);
    }
#pragma unroll
    for (int i = 0; i < 8; ++i) {
        const int p = tid + NTHREADS * i, r = p >> 6, c = p & 63;
        if (p < 3968) { *(LAS v4u*)(lds + r * 1040 + c * 16) = st[i]; *(LAS f32x4*)(Wl + p * 16) = sw[i]; }
    }
    __syncthreads();
    const int c0 = 8 * lane;
    f32x2 acc[4][4];
#pragma unroll
    for (int t = 0; t < 4; ++t)
#pragma unroll
        for (int k = 0; k < 4; ++k) acc[t][k] = (f32x2){0.f, 0.f};
    ldsp rb = lds + (4 * wid) * 1040 + lane * 16; ldsp wb = Wl + lane * 32;
#pragma unroll 1
    for (int j = 0; j < 31; ++j) {
        const f32x4 w0 = *(const LAS f32x4*)(wb + j * 2048), w1 = *(const LAS f32x4*)(wb + j * 2048 + 16);
        const f32x2 wv[4] = {{w0[0], w0[1]}, {w0[2], w0[3]}, {w1[0], w1[1]}, {w1[2], w1[3]}};
#pragma unroll
        for (int t = 0; t < 4; ++t) {
            const v4u hv = *(const LAS v4u*)(rb + (t + j) * 1040);
#pragma unroll
            for (int k = 0; k < 4; ++k) { const f32x2 h2 = {bflo(hv[k]), bfhi(hv[k])}; acc[t][k] += h2 * wv[k]; }
        }
    }
    const f32x4 bb0 = *(const f32x4*)(dw_b + c0), bb1 = *(const f32x4*)(dw_b + c0 + 4), g0 = *(const f32x4*)(ln_g + c0), g1 = *(const f32x4*)(ln_g + c0 + 4), e0 = *(const f32x4*)(ln_b + c0), e1 = *(const f32x4*)(ln_b + c0 + 4);
#pragma unroll
    for (int t = 0; t < 4; ++t) {
        f32x4 y0 = (f32x4){acc[t][0][0], acc[t][0][1], acc[t][1][0], acc[t][1][1]} + bb0, y1 = (f32x4){acc[t][2][0], acc[t][2][1], acc[t][3][0], acc[t][3][1]} + bb1;
        const float s = (y0[0] + y0[1]) + (y0[2] + y0[3]) + (y1[0] + y1[1]) + (y1[2] + y1[3]);
        const float mean = wave_sum(s) * (1.0f / 512.0f);
        y0 = y0 - mean; y1 = y1 - mean;
        const float q = (y0[0] * y0[0] + y0[1] * y0[1]) + (y0[2] * y0[2] + y0[3] * y0[3]) + (y1[0] * y1[0] + y1[1] * y1[1]) + (y1[2] * y1[2] + y1[3] * y1[3]);
        const float rstd = __builtin_amdgcn_rsqf(wave_sum(q) * (1.0f / 512.0f) + EPS);
        y0 = y0 * rstd * g0 + e0; y1 = y1 * rstd * g1 + e1;
#pragma unroll
        for (int c = 0; c < 4; ++c) { y0[c] = y0[c] * fast_sigmoid(y0[c]); y1[c] = y1[c] * fast_sigmoid(y1[c]); }
        v4u w; w.x = pk(y0[0], y0[1]); w.y = pk(y0[2], y0[3]); w.z = pk(y1[0], y1[1]); w.w = pk(y1[2], y1[3]);
        *(v4u*)(MX + (size_t)(tok0 + 4 * wid + t) * D + 1024 + c0) = w;
    }
    __syncthreads();
}

__device__ __forceinline__ void sgu_unit(ldsp lds, const bf16* P, bf16* MX, const float* ln_g, const float* ln_b, const float* w_s, const float* b_s, int ck, int hf, int tid) {
    const int lane = tid & 63, wid = tid >> 6, fr = lane & 15, fq = lane >> 4;
    const int tok0 = 128 * ck, c0 = 8 * lane;
    const int hl = wid >> 1, hh = 4 * hf + hl, th = wid & 1;
    {
        const f32x4 g0 = *(const f32x4*)(ln_g + c0), g1 = *(const f32x4*)(ln_g + c0 + 4), e0 = *(const f32x4*)(ln_b + c0), e1 = *(const f32x4*)(ln_b + c0 + 4);
#pragma unroll 1
        for (int i4 = 0; i4 < 16; i4 += 4) {
        v4u raw4[4];
#pragma unroll
        for (int i = 0; i < 4; ++i) raw4[i] = *(const v4u*)(P + (size_t)(tok0 + 16 * wid + i4 + i) * PW + 2560 + c0);
#pragma unroll
        for (int i = 0; i < 4; ++i) {
            const int sidx = 16 * wid + i4 + i; const v4u rw = raw4[i];
            float v[8] = {bflo(rw.x), bfhi(rw.x), bflo(rw.y), bfhi(rw.y), bflo(rw.z), bfhi(rw.z), bflo(rw.w), bfhi(rw.w)};
            float s = 0.f;
#pragma unroll
            for (int c = 0; c < 8; ++c) s += v[c];
            const float mean = wave_sum(s) * (1.0f / 512.0f); float q = 0.f;
#pragma unroll
            for (int c = 0; c < 8; ++c) { v[c] -= mean; q += v[c] * v[c]; }
            const float rstd = __builtin_amdgcn_rsqf(wave_sum(q) * (1.0f / 512.0f) + EPS);
            if ((lane >> 5) == hf) {
#pragma unroll
                for (int c = 0; c < 8; ++c) { const float vn = v[c] * rstd * (c < 4 ? g0[c & 3] : g1[c & 3]) + (c < 4 ? e0[c & 3] : e1[c & 3]);
                    *(LAS unsigned short*)(lds + ((c0 & 255) + c) * 272 + 2 * sidx) = (unsigned short)(pk(vn, 0.f) & 0xffffu); }
            }
        }
        }
    }
    __syncthreads();
#pragma unroll 1
    for (int m = 0; m < 4; ++m) {
        const int t0 = 64 * th + 16 * m, t = t0 + fr;
        f32x4 acc[4];
#pragma unroll
        for (int nd = 0; nd < 4; ++nd) acc[nd] = (f32x4){0.f, 0.f, 0.f, 0.f};
        const float* wrow = w_s + ((size_t)hh * 128 + t) * 128;
        const int nks = (t0 + 15) / 32 + 1;
        f32x4 wa[4], wb[4];
#pragma unroll
        for (int ks = 0; ks < 4; ++ks) { const int kk = ks < nks ? ks : 0; wa[ks] = *(const f32x4*)(wrow + 32 * kk + 8 * fq); wb[ks] = *(const f32x4*)(wrow + 32 * kk + 8 * fq + 4); }
        const float bias = b_s[hh * 128 + t];
        v2u uu[4];
#pragma unroll
        for (int nd = 0; nd < 4; ++nd) uu[nd] = *(const v2u*)(P + (size_t)(tok0 + t) * PW + 2048 + 64 * hh + 16 * nd + 4 * fq);
#pragma unroll
        for (int ks = 0; ks < 4; ++ks) {
            if (ks < nks) {
                const int sb = 32 * ks + 8 * fq;
                f32x4 xa = wa[ks], xb = wb[ks];
#pragma unroll
                for (int i = 0; i < 4; ++i) { xa[i] = (sb + i <= t) ? xa[i] : 0.f; xb[i] = (sb + 4 + i <= t) ? xb[i] : 0.f; }
                v4u ww; ww.x = pk(xa[0], xa[1]); ww.y = pk(xa[2], xa[3]); ww.z = pk(xb[0], xb[1]); ww.w = pk(xb[2], xb[3]);
                const bf16x8 wf = __builtin_bit_cast(bf16x8, ww);
#pragma unroll
                for (int nd = 0; nd < 4; ++nd) {
                    const bf16x8 vf = *(const LAS bf16x8*)(lds + (64 * hl + 16 * nd + fr) * 272 + 64 * ks + 16 * fq);
                    acc[nd] = MFMA16(vf, wf, acc[nd]);
                }
            }
        }
#pragma unroll
        for (int nd = 0; nd < 4; ++nd) {
            const int ch = 64 * hh + 16 * nd + 4 * fq;
            v2u w; w.x = pk((acc[nd][0] + bias) * bflo(uu[nd].x), (acc[nd][1] + bias) * bfhi(uu[nd].x)); w.y = pk((acc[nd][2] + bias) * bflo(uu[nd].y), (acc[nd][3] + bias) * bfhi(uu[nd].y));
            *(v2u*)(MX + (size_t)(tok0 + t) * D + 1536 + ch) = w;
        }
    }
    __syncthreads();
}

#define XB_TMO      128
#define XB_XCNT(j)  (256  + 64 * (j))
#define XB_XSUB(j)  (1280 + 64 * (j))
#define XB_XGEN(j)  (2304 + 64 * (j))
#define XB_TOP      3328
#define XB_TOPGEN   3392
#define XCD_BAR_WORDS 3456
#define XB_SPIN_CAP (1u << 23)

__device__ __forceinline__ unsigned xb_ld(unsigned* p)              { return __hip_atomic_load(p, __ATOMIC_RELAXED, __HIP_MEMORY_SCOPE_AGENT); }
__device__ __forceinline__ unsigned xb_add(unsigned* p, unsigned v) { return __hip_atomic_fetch_add(p, v, __ATOMIC_RELAXED, __HIP_MEMORY_SCOPE_AGENT); }
__device__ __forceinline__ unsigned xb_xcc_id() { return (unsigned)__builtin_amdgcn_s_getreg((3 << 11) | 20) & 0xFu; }
#define XB_SPIN(cond, bar) do { unsigned _sp = 0; while (cond) { __builtin_amdgcn_s_sleep(1); \
    if ((++_sp & 255u) == 0u) { if (xb_ld(&(bar)[XB_TMO])) break; if (_sp > XB_SPIN_CAP) { atomicAdd(&(bar)[XB_TMO], 1u); break; } } } } while (0)

struct XcdBarrier {
    unsigned* bar; unsigned x;
    volatile LAS unsigned* st;
};

__device__ __forceinline__ XcdBarrier xcd_barrier_post(unsigned* bar, volatile LAS unsigned* st) {
    XcdBarrier b; b.bar = bar; b.x = xb_xcc_id(); b.st = st;
    if (threadIdx.x == 0) (void)xb_add(&bar[XB_XCNT(b.x)], 1u);
    return b;
}
__device__ __forceinline__ void xcd_barrier_complete(unsigned* bar, unsigned x, unsigned& nloc, unsigned& nx) {
    const unsigned G = gridDim.x * gridDim.y * gridDim.z;
    unsigned sum, cnt, mine, sp = 0u;
    for (;;) {
        sum = 0u; cnt = 0u; mine = 0u;
#pragma unroll
        for (unsigned j = 0; j < 16; ++j) { const unsigned c = xb_ld(&bar[XB_XCNT(j)]); sum += c; cnt += (c > 0u) ? 1u : 0u; mine = (j == x) ? c : mine; }
        if (sum == G) break;
        __builtin_amdgcn_s_sleep(1);
        if ((++sp & 255u) == 0u) { if (xb_ld(&bar[XB_TMO])) break; if (sp > XB_SPIN_CAP) { atomicAdd(&bar[XB_TMO], 1u); break; } }
    }
    nloc = mine > 0u ? mine : 1u; nx = cnt > 0u ? cnt : 1u;
}

__device__ __forceinline__ void xcd_barrier(const XcdBarrier& b) {
    asm volatile("s_waitcnt vmcnt(0)" ::: "memory");
    __syncthreads();
    if (threadIdx.x == 0) {
        unsigned* bar = b.bar;
        __builtin_amdgcn_s_waitcnt(0);
        unsigned nloc = b.st[0], nx = b.st[1];
        if (nloc == 0u) { xcd_barrier_complete(bar, b.x, nloc, nx); b.st[0] = nloc; b.st[1] = nx; }
        const unsigned old = xb_add(&bar[XB_XSUB(b.x)], 1u);
        const unsigned gen = old / nloc;
        if (old + 1u == (gen + 1u) * nloc) {
            __builtin_amdgcn_fence(__ATOMIC_RELEASE, "agent");
            asm volatile("s_waitcnt vmcnt(0)" ::: "memory");
            const unsigned og = xb_add(&bar[XB_TOP], 1u);
            const unsigned tg = og / nx;
            if (og + 1u == (tg + 1u) * nx) xb_add(&bar[XB_TOPGEN], 1u);
            else XB_SPIN(xb_ld(&bar[XB_TOPGEN]) == tg, bar);
            __builtin_amdgcn_fence(__ATOMIC_ACQUIRE, "agent");
            xb_add(&bar[XB_XGEN(b.x)], 1u);
            asm volatile("s_waitcnt vmcnt(0)" ::: "memory");
        } else {
            XB_SPIN(xb_ld(&bar[XB_XGEN(b.x)]) == gen, bar);
            __builtin_amdgcn_fence(__ATOMIC_ACQUIRE, "agent");
            asm volatile("s_waitcnt vmcnt(0)" ::: "memory");
        }
    }
    __syncthreads();
}

__device__ __forceinline__ void build_rtab(LAS float* rtab, const float* part, int rowbase, int tid) {
#pragma unroll 1
    for (int i = tid; i < 2048; i += NTHREADS) {
        const f32x4* p = (const f32x4*)(part + (size_t)(rowbase + i) * 32);
        f32x4 v[8];
#pragma unroll
        for (int k = 0; k < 8; ++k) v[k] = p[k];
        float s = 0.f;
#pragma unroll
        for (int k = 0; k < 8; ++k) s += (v[k][0] + v[k][1]) + (v[k][2] + v[k][3]);
        rtab[i] = __builtin_amdgcn_rsqf(s * (1.0f / D) + EPS);
    }
    __syncthreads();
}

typedef const __attribute__((address_space(4))) Args* kargp;
__device__ __forceinline__ kargp kargs() { kargp p = (kargp)__builtin_amdgcn_kernarg_segment_ptr(); asm volatile("" : "+s"(p)); return p; }
__global__ void __launch_bounds__(NTHREADS, 2) fwd_megakernel(Args a_unused) {
    extern __shared__ __attribute__((aligned(16))) unsigned char lds_raw[];
    cg::grid_group grid = cg::this_grid();
    ldsp lds = (ldsp)lds_raw;
    const int tid = threadIdx.x, lane = tid & 63, wave = __builtin_amdgcn_readfirstlane(tid >> 6);
    const int G = gridDim.x, bid = blockIdx.x;
    const int gw = bid * NWAVES + wave, NGW = G * NWAVES, gtid = bid * NTHREADS + tid, NGT = G * NTHREADS;
    unsigned char* ws = kargs()->ws;

#ifndef PROBE_PRO
#define PROBE_PRO 1
#endif
#ifndef PROBE_MIX
#define PROBE_MIX 1
#endif
#ifndef PROBE_FFI
#define PROBE_FFI 1
#endif
    volatile LAS unsigned* bar_st = (volatile LAS unsigned*)(lds + LDS_BYTES - 64);
    if (tid < 2) bar_st[tid] = 0u;
    if (bid == 0) { unsigned* bw = (unsigned*)a_unused.ws; for (int i = tid; i < XCD_BAR_WORDS; i += NTHREADS) bw[i] = 0u; }
    for (int rep = 0; rep < PROBE_PRO; ++rep) prologue(a_unused, lds, gw, NGW, lane, wave);
    prologue_rows(a_unused, gw, NGW, lane, gtid, NGT);
    grid.sync();
    const XcdBarrier xbar = xcd_barrier_post((unsigned*)ws, bar_st);

    for (int step = 0; step < 6; ++step) {
        const int l = step / 3, sub = step % 3;
        ws = kargs()->ws; const unsigned char* wl = ws + WS_W + (size_t)l * WL_SIZE;
        float* partb = (float*)(ws + WS_PART); const float* cs = (const float*)(ws + WS_CS); LAS float* rtab = (LAS float*)(lds + 131072);
        bf16* XB = (bf16*)(ws + WS_XB); bf16* ACT = (bf16*)(ws + WS_ACT); bf16* PB = (bf16*)(ws + WS_P); bf16* MX = (bf16*)(ws + WS_MX);
        const float* part_in = partb + (size_t)step * M * 32; float* part_out = partb + (size_t)(step + 1) * M * 32;
        const bf16* A2; const bf16* B2; int K2; float scale;
        if (sub != 1) {
            pg8::Gemm g{XB, (const bf16*)(wl + (sub == 0 ? WL_F1I : WL_F2I)), M, NFF, D}; pg8::StaticOrder S; S.init(M, NFF, G, bid);
            pg8::Unit u0; int rowbase = 0; if (S.next(0, u0)) rowbase = (u0.pm & ~7) * 256;
            { int tl = threadIdx.x; asm volatile("" : "+v"(tl)); build_rtab(rtab, part_in, rowbase, tl); }
            EpiSwiGLU E{ACT, rtab, rowbase};
            for (int rep = 0; rep < PROBE_FFI; ++rep) pg8::gemm_phase<EpiSwiGLU, pg8::StaticOrder, true, true>(lds, g, S, E);
            xcd_barrier(xbar);
            A2 = ACT; B2 = (const bf16*)(wl + (sub == 0 ? WL_F1O : WL_F2O)); K2 = FF; scale = 0.5f;
        } else {
            {
                pg8::Gemm g{XB, (const bf16*)(wl + WL_IN), M, NIN, D}; pg8::StaticOrder S; S.init(M, NIN, G, bid);
                pg8::Unit u0; int rowbase = 0; if (S.next(0, u0)) rowbase = (u0.pm & ~7) * 256;
                { int tl = threadIdx.x; asm volatile("" : "+v"(tl)); build_rtab(rtab, part_in, rowbase, tl); }
                EpiMixIn E{PB, rtab, rowbase, cs};
                pg8::gemm_phase<EpiMixIn, pg8::StaticOrder, true, true>(lds, g, S, E);
            }
            xcd_barrier(xbar);
            for (int rep = 0; rep < PROBE_MIX; ++rep)
            for (int u = bid; u < 1280; u += G) {
                kargp a = kargs(); int tl = threadIdx.x; asm volatile("" : "+v"(tl));
                if (u < 512) attn_unit(lds, PB, MX, a->attn_sinks + l * 16, u >> 7, (u & 127) >> 2, u & 3, tl);
                else if (u < 1024) conv_unit(lds, PB, MX, a->conv_dw_w + (size_t)l * 31 * 512, a->conv_dw_b + l * 512, a->conv_ln_g + l * 512, a->conv_ln_b + l * 512, u - 512, tl);
                else sgu_unit(lds, PB, MX, a->sgu_ln_g + l * 512, a->sgu_ln_b + l * 512, a->sgu_w + (size_t)l * 8 * 128 * 128, a->sgu_b + l * 8 * 128, (u - 1024) >> 1, (u - 1024) & 1, tl);
            }
            xcd_barrier(xbar);
            A2 = MX; B2 = (const bf16*)(wl + WL_OUT); K2 = D; scale = 1.0f;
        }
        {
            pg8::Gemm g{A2, B2, M, D, K2}; pg8::StaticOrder S; S.init(M, D, G, bid);
            EpiResid E{XB, part_out, scale};
            pg8::gemm_phase<EpiResid, pg8::StaticOrder, true, true>(lds, g, S, E);
        }
        xcd_barrier(xbar);
    }
    {
        kargp a = kargs(); const float* part = (const float*)(a->ws + WS_PART) + (size_t)6 * M * 32; float* outp = a->out; const float* fng = a->final_norm; const bf16* XBf = (const bf16*)(a->ws + WS_XB);
        for (int m = gw; m < M; m += NGW) {
            const float r = __builtin_amdgcn_rsqf(wave_sum(lane < 32 ? part[(size_t)m * 32 + lane] : 0.f) * (1.0f / D) + EPS);
            const v4u* xr = (const v4u*)(XBf + (size_t)m * D) + lane; f32x4* orow = (f32x4*)(outp + (size_t)m * D); const f32x4* gr = (const f32x4*)fng;
#pragma unroll
            for (int j = 0; j < 4; ++j) {
                const v4u b = xr[64 * j]; const int c4 = 2 * (lane + 64 * j);
                const f32x4 x0 = {bflo(b.x), bfhi(b.x), bflo(b.y), bfhi(b.y)}, x1 = {bflo(b.z), bfhi(b.z), bflo(b.w), bfhi(b.w)};
                orow[c4] = x0 * r * gr[c4]; orow[c4 + 1] = x1 * r * gr[c4 + 1];
            }
        }
    }
}

extern "C" void kernel_launch(void* const* d_in, const int* in_sizes, int n_in, void* d_out, int out_size, void* d_ws, size_t ws_size, hipStream_t stream) {
    static int grid_blocks = 0;
    if (grid_blocks == 0) {
        if (n_in != 21 || out_size != M * D || ws_size < WS_END) { fprintf(stderr, "kernel_launch: unexpected shapes (n_in %d out %d ws %zu need %zu)\n", n_in, out_size, ws_size, (size_t)WS_END); grid_blocks = -1; return; }
        int dev = 0, cus = 0, per_cu = 0;
        (void)hipGetDevice(&dev);
        (void)hipDeviceGetAttribute(&cus, hipDeviceAttributeMultiprocessorCount, dev);
        if (hipFuncSetAttribute((const void*)fwd_megakernel, hipFuncAttributeMaxDynamicSharedMemorySize, LDS_BYTES) != hipSuccess) { fprintf(stderr, "kernel_launch: hipFuncSetAttribute failed\n"); grid_blocks = -1; return; }
        if (hipOccupancyMaxActiveBlocksPerMultiprocessor(&per_cu, (const void*)fwd_megakernel, NTHREADS, LDS_BYTES) != hipSuccess || per_cu < 1) { fprintf(stderr, "kernel_launch: occupancy query says %d\n", per_cu); per_cu = 1; (void)hipGetLastError(); }
        grid_blocks = cus * per_cu;
    }
    if (grid_blocks < 0) return;
    Args a{};
    a.x = (const float*)d_in[0]; a.pos = (const int*)d_in[1];
    a.norm_ffn1 = (const float*)d_in[2]; a.ffn1_w_in = (const float*)d_in[3]; a.ffn1_w_out = (const float*)d_in[4]; a.norm_mix = (const float*)d_in[5]; a.w_in = (const float*)d_in[6];
    a.conv_dw_w = (const float*)d_in[7]; a.conv_dw_b = (const float*)d_in[8]; a.conv_ln_g = (const float*)d_in[9]; a.conv_ln_b = (const float*)d_in[10];
    a.sgu_ln_g = (const float*)d_in[11]; a.sgu_ln_b = (const float*)d_in[12]; a.sgu_w = (const float*)d_in[13]; a.sgu_b = (const float*)d_in[14]; a.attn_sinks = (const float*)d_in[15];
    a.w_out = (const float*)d_in[16]; a.norm_ffn2 = (const float*)d_in[17]; a.ffn2_w_in = (const float*)d_in[18]; a.ffn2_w_out = (const float*)d_in[19]; a.final_norm = (const float*)d_in[20];
    a.out = (float*)d_out; a.ws = (unsigned char*)d_ws;
    void* args[] = {&a};
    hipError_t e = hipLaunchCooperativeKernel((const void*)fwd_megakernel, dim3(grid_blocks), dim3(NTHREADS), args, LDS_BYTES, stream);
    if (e != hipSuccess) fprintf(stderr, "kernel_launch: cooperative launch failed: %s (grid %d)\n", hipGetErrorString(e), grid_blocks);
}
```

```cpp
#include <hip/hip_runtime.h>
#include <hip/hip_cooperative_groups.h>
#include <cstdio>
#include <cstdint>
namespace cg = cooperative_groups;
namespace pg8 {
#define PG8_LAS __attribute__((address_space(3)))
typedef unsigned short bf16_t;
typedef short bf16x8 __attribute__((ext_vector_type(8)));
typedef float f32x4 __attribute__((ext_vector_type(4)));
typedef unsigned u32x4 __attribute__((ext_vector_type(4)));
constexpr int BM = 256, BK = 64, HALF = 128, HTB = HALF * BK * 2  , STAGE_BYTES = 8 * HTB, NXCD = 8, WGM = 8;

__host__ __device__ __forceinline__ int lds_byte(int r, int c) { const int st = (r >> 4) * 2 + (c >> 5), rr = r & 15, cc = c & 31, ob = rr * 64 + cc * 2; return st * 1024 + (ob ^ (((ob >> 9) & 1) << 5)); }
__host__ __device__ __forceinline__ void stage_rc(int b, int& R, int& C) { const int st = b / 1024, sb = b % 1024, swz = sb ^ (((sb >> 9) & 1) << 5); R = (st >> 1) * 16 + swz / 64; C = (st & 1) * 32 + (swz % 64) / 2; }
__host__ __device__ __forceinline__ int perm32(int rho) { const int n = rho >> 4, i = rho & 15; return 8 * (i >> 2) + 4 * n + (i & 3); }

struct Unit { int pm, pn; };
struct Gemm { const bf16_t* A; const bf16_t* Bt; int M, N, K; };

struct StaticOrder {
    int nM, nN, nwg, G, c;
    __host__ __device__ void init(int M, int N, int G_, int c_) { nM = M / BM; nN = N / BM; nwg = nM * nN; G = G_; c = c_; }
    __host__ __device__ bool next(int i, Unit& u) const {
        const long L = (long)i * G + c; if (L >= nwg) return false;
        int wgid = (int)L; { const int q = nwg / NXCD, r = nwg % NXCD, xcd = wgid % NXCD, off = wgid / NXCD; wgid = (xcd < r ? xcd * (q + 1) : r * (q + 1) + (xcd - r) * q) + off; }
        const int nig = WGM * nN, gid = wgid / nig, fm = gid * WGM, gsz = (nM - fm) < WGM ? (nM - fm) : WGM;
        u.pm = fm + ((wgid % nig) % gsz); u.pn = (wgid % nig) / gsz; return true;
    }
    __device__ __forceinline__ void a_ready(const Unit&) const {}
    __device__ __forceinline__ void done(const Unit&) const {}
};

__device__ __forceinline__ unsigned cvt_pk_bf16(float lo, float hi) { unsigned r; asm volatile("v_cvt_pk_bf16_f32 %0, %1, %2" : "=v"(r) : "v"(lo), "v"(hi)); return r; }
typedef float f32x2 __attribute__((ext_vector_type(2)));
template <class Epi, class Sched, bool ALIGN_EPI = false, bool SP2 = false>
__device__ __forceinline__ void gemm_phase(PG8_LAS unsigned char* lds, const Gemm g, const Sched& S, const Epi& E) {
    int tid_ = threadIdx.x; asm volatile("" : "+v"(tid_));
    const int tid = tid_, wid = __builtin_amdgcn_readfirstlane(tid >> 6), lane = tid & 63, wr = wid >> 2, wc = wid & 3, fr = lane & 15, fq = lane >> 4;
    const int K = g.K, nt = K / BK;
    unsigned voffA[2], voffB[2];
#pragma unroll
    for (int i = 0; i < 2; ++i) { int R, C; stage_rc(tid * 16 + i * 8192, R, C); const int Rb = Epi::PERM ? ((R & ~31) + perm32(R & 31)) : R;
        voffA[i] = (unsigned)(R * K + C) * 2u; voffB[i] = (unsigned)(Rb * BK + C) * 2u; }
    const size_t kstep = (size_t)(BK * 2);
    const size_t hstep = (size_t)HALF * K * 2;
    const size_t tstep = 2 * hstep;
    const size_t kstepB = (size_t)g.N * BK * 2, hstepB = (size_t)HALF * BK * 2, tstepB = 2 * hstepB;
    const unsigned ldsw = (unsigned)wid * 1024u;
    const int aoff = lds_byte(wr * 64 + fr, fq * 8), boff = lds_byte(wc * 32 + fr, fq * 8);
#define PG8_SA(b, h) (((b) * 2 + (h)) * HTB)
#define PG8_SB(b, h) ((4 + (b) * 2 + (h)) * HTB)
#define PG8_STAGE(bufoff, gbase, voff) do { _Pragma("unroll") for (int _i = 0; _i < 2; ++_i) \
        __builtin_amdgcn_global_load_lds((const unsigned*)((const char*)(gbase) + (voff)[_i]), (PG8_LAS unsigned*)(lds + (bufoff) + ldsw + _i * 8192), 16, 0, 0); } while (0)
#define PG8_LDA(dst, b, h) do { _Pragma("unroll") for (int m = 0; m < 4; ++m) _Pragma("unroll") for (int k = 0; k < 2; ++k) dst[m][k] = *(const PG8_LAS bf16x8*)(lds + PG8_SA(b, h) + aoff + m * 2048 + k * 1024); } while (0)
#define PG8_LDB(dst, b, h) do { _Pragma("unroll") for (int n = 0; n < 2; ++n) _Pragma("unroll") for (int k = 0; k < 2; ++k) dst[n][k] = *(const PG8_LAS bf16x8*)(lds + PG8_SB(b, h) + boff + n * 2048 + k * 1024); } while (0)
#define PG8_MMA(ai, bj, At, Bt) do { __builtin_amdgcn_s_setprio(1); _Pragma("unroll") for (int m = 0; m < 4; ++m) _Pragma("unroll") for (int n = 0; n < 2; ++n) _Pragma("unroll") for (int k = 0; k < 2; ++k) \
        acc[ai][bj][m][n] = __builtin_amdgcn_mfma_f32_16x16x32_bf16(Bt[n][k], At[m][k], acc[ai][bj][m][n], 0, 0, 0); __builtin_amdgcn_s_setprio(0); } while (0)
#define PG8_WAIT_V(n) asm volatile("s_waitcnt vmcnt(" #n ")" ::: "memory")
#define PG8_WAIT_L(n) asm volatile("s_waitcnt lgkmcnt(" #n ")" ::: "memory")
#define PG8_BAR __builtin_amdgcn_s_barrier()
#define PG8_SCHED __builtin_amdgcn_sched_barrier(0)
    Unit cur, nxt; int ui = 0;
    if (!S.next(0, cur)) return;
    f32x4 acc[2][2][4][2];
#pragma unroll
    for (int a = 0; a < 2; ++a)
#pragma unroll
        for (int b = 0; b < 2; ++b)
#pragma unroll
            for (int m = 0; m < 4; ++m)
#pragma unroll
                for (int n = 0; n < 2; ++n) acc[a][b][m][n] = (f32x4){0.f, 0.f, 0.f, 0.f};
    bf16x8 At[4][2], B0[2][2], B1[2][2];
    const char* cA = (const char*)g.A + (size_t)cur.pm * tstep; const char* cB = (const char*)g.Bt + (size_t)cur.pn * tstepB;
    S.a_ready(cur);
    if constexpr (SP2) {
        PG8_STAGE(PG8_SB(0, 0), cB, voffB); PG8_STAGE(PG8_SB(0, 1), cB + hstepB, voffB); PG8_STAGE(PG8_SA(0, 0), cA, voffA); PG8_STAGE(PG8_SA(0, 1), cA + hstep, voffA);
        if (wr == 1) PG8_BAR;
        PG8_WAIT_V(2); PG8_BAR;
        PG8_STAGE(PG8_SB(1, 0), cB + kstepB, voffB); PG8_STAGE(PG8_SA(1, 0), cA + kstep, voffA); PG8_STAGE(PG8_SB(1, 1), cB + hstepB + kstepB, voffB);
        PG8_WAIT_V(6); PG8_BAR;
    } else {
        PG8_STAGE(PG8_SB(0, 0), cB, voffB); PG8_STAGE(PG8_SA(0, 0), cA, voffA); PG8_STAGE(PG8_SB(0, 1), cB + hstepB, voffB); PG8_STAGE(PG8_SA(0, 1), cA + hstep, voffA);
        if (wr == 1) PG8_BAR;
        PG8_WAIT_V(4); PG8_BAR;
        PG8_STAGE(PG8_SB(1, 0), cB + kstepB, voffB); PG8_STAGE(PG8_SA(1, 0), cA + kstep, voffA); PG8_STAGE(PG8_SB(1, 1), cB + hstepB + kstepB, voffB);
        PG8_WAIT_V(6); PG8_BAR;
    }
    for (;;) {
        const bool has_next = S.next(ui + 1, nxt);
        const char* nA = has_next ? (const char*)g.A + (size_t)nxt.pm * tstep : cA; const char* nB = has_next ? (const char*)g.Bt + (size_t)nxt.pn * tstepB : cB;
        for (int t = 0; t < nt; t += 2) {
            const bool last = (t == nt - 2);
            const char* a1 = cA + (size_t)(t + 1) * kstep;
            const char* a2 = last ? nA : cA + (size_t)(t + 2) * kstep; const char* b2 = last ? nB : cB + (size_t)(t + 2) * kstepB;
            const char* a3 = a2 + kstep; const char* b3 = b2 + kstepB;
            if (last && has_next) S.a_ready(nxt);
            if constexpr (SP2) {
            PG8_LDB(B0, 0, 0); PG8_LDB(B1, 0, 1); PG8_SCHED; PG8_LDA(At, 0, 0); PG8_STAGE(PG8_SA(1, 1), a1 + hstep, voffA);
            PG8_WAIT_V(8); PG8_WAIT_L(0); PG8_BAR; PG8_MMA(0, 0, At, B0); PG8_MMA(0, 1, At, B1); PG8_BAR; PG8_SCHED;
            PG8_LDA(At, 0, 1); PG8_STAGE(PG8_SB(0, 0), b2, voffB); PG8_STAGE(PG8_SB(0, 1), b2 + hstepB, voffB); PG8_STAGE(PG8_SA(0, 0), a2, voffA);
            PG8_WAIT_V(8); PG8_WAIT_L(0); PG8_BAR; PG8_MMA(1, 0, At, B0); PG8_MMA(1, 1, At, B1); PG8_BAR; PG8_SCHED;
            PG8_LDB(B0, 1, 0); PG8_LDB(B1, 1, 1); PG8_SCHED; PG8_LDA(At, 1, 0); PG8_STAGE(PG8_SA(0, 1), a2 + hstep, voffA);
            PG8_WAIT_V(8); PG8_WAIT_L(0); PG8_BAR; PG8_MMA(0, 0, At, B0); PG8_MMA(0, 1, At, B1); PG8_BAR; PG8_SCHED;
            PG8_LDA(At, 1, 1); PG8_STAGE(PG8_SB(1, 0), b3, voffB); PG8_STAGE(PG8_SB(1, 1), b3 + hstepB, voffB); PG8_STAGE(PG8_SA(1, 0), a3, voffA);
            PG8_WAIT_V(8); PG8_WAIT_L(0); PG8_BAR; PG8_MMA(1, 0, At, B0); PG8_MMA(1, 1, At, B1); PG8_BAR; PG8_SCHED;
            } else {
            PG8_LDB(B0, 0, 0); PG8_SCHED; PG8_LDA(At, 0, 0); PG8_STAGE(PG8_SA(1, 1), a1 + hstep, voffA);
            PG8_WAIT_L(8); PG8_BAR; PG8_WAIT_L(0); PG8_MMA(0, 0, At, B0); PG8_BAR; PG8_SCHED;
            PG8_LDB(B1, 0, 1); PG8_STAGE(PG8_SB(0, 0), b2, voffB);
            PG8_BAR; PG8_WAIT_L(0); PG8_MMA(0, 1, At, B1); PG8_BAR;
            PG8_LDA(At, 0, 1); PG8_STAGE(PG8_SA(0, 0), a2, voffA);
            PG8_BAR; PG8_WAIT_L(0); PG8_MMA(1, 0, At, B0); PG8_BAR; PG8_SCHED;
            PG8_STAGE(PG8_SB(0, 1), b2 + hstepB, voffB);
            PG8_WAIT_V(6); PG8_BAR; PG8_MMA(1, 1, At, B1); PG8_BAR;
            PG8_LDB(B0, 1, 0); PG8_SCHED; PG8_LDA(At, 1, 0); PG8_STAGE(PG8_SA(0, 1), a2 + hstep, voffA);
            PG8_WAIT_L(8); PG8_BAR; PG8_WAIT_L(0); PG8_MMA(0, 0, At, B0); PG8_BAR; PG8_SCHED;
            PG8_LDB(B1, 1, 1); PG8_STAGE(PG8_SB(1, 0), b3, voffB);
            PG8_BAR; PG8_WAIT_L(0); PG8_MMA(0, 1, At, B1); PG8_BAR;
            PG8_LDA(At, 1, 1); PG8_STAGE(PG8_SA(1, 0), a3, voffA);
            PG8_BAR; PG8_WAIT_L(0); PG8_MMA(1, 0, At, B0); PG8_BAR; PG8_SCHED;
            PG8_STAGE(PG8_SB(1, 1), b3 + hstepB, voffB);
            PG8_WAIT_V(6); PG8_BAR; PG8_MMA(1, 1, At, B1); PG8_BAR;
            }
        }
        if constexpr (ALIGN_EPI) { if (wr == 0) PG8_BAR; }
        if constexpr (!Epi::AFTER_DRAIN) { E(acc, cur, wr, wc, fr, fq); S.done(cur); }
        if (!has_next) break;
#pragma unroll
        for (int a = 0; a < 2; ++a)
#pragma unroll
            for (int b = 0; b < 2; ++b)
#pragma unroll
                for (int m = 0; m < 4; ++m)
#pragma unroll
                    for (int n = 0; n < 2; ++n) acc[a][b][m][n] = (f32x4){0.f, 0.f, 0.f, 0.f};
        cur = nxt; cA = nA; cB = nB; ++ui;
        if constexpr (ALIGN_EPI) { if (wr == 1) PG8_BAR; }
    }
    PG8_WAIT_V(0);
    if constexpr (!ALIGN_EPI) { if (wr == 0) PG8_BAR; }
    PG8_BAR;
    if constexpr (Epi::AFTER_DRAIN) { E.fused(acc, cur, wr, wc, fr, fq, lds, wid, lane); S.done(cur); }
#undef PG8_SA
#undef PG8_SB
#undef PG8_STAGE
#undef PG8_LDA
#undef PG8_LDB
#undef PG8_MMA
#undef PG8_WAIT_V
#undef PG8_WAIT_L
#undef PG8_BAR
#undef PG8_SCHED
}
}

#define LAS __attribute__((address_space(3)))
typedef unsigned short bf16;
typedef unsigned v4u __attribute__((ext_vector_type(4)));
typedef unsigned v2u __attribute__((ext_vector_type(2)));
typedef float f32x4 __attribute__((ext_vector_type(4)));
typedef short bf16x8 __attribute__((ext_vector_type(8)));
typedef LAS unsigned char* ldsp;

constexpr int M = 16384, D = 2048, FF = 5632, NFF = 2 * FF, NIN = 3584, PW = 3072, SEQ = 4096;
constexpr float EPS = 1e-5f, LOG2E = 1.4426950408889634f;
constexpr int NTHREADS = 512, NWAVES = 8;
constexpr int LDS_BYTES = 147456;

constexpr size_t MiB = 1u << 20;
constexpr size_t WS_SS = 1 * MiB;
constexpr size_t WS_CS = 2 * MiB;
constexpr size_t WS_W = 4 * MiB;
constexpr size_t WL_F1I = 0, WL_F1O = 44 * MiB, WL_IN = 66 * MiB, WL_OUT = 80 * MiB, WL_F2I = 88 * MiB, WL_F2O = 132 * MiB, WL_SIZE = 154 * MiB;
constexpr size_t WS_XB = WS_W + 2 * WL_SIZE;
constexpr size_t WS_ACT = WS_XB + 64 * MiB;
constexpr size_t WS_P = WS_ACT, WS_MX = WS_ACT + 96 * MiB;
constexpr size_t WS_PART = WS_ACT + 176 * MiB;
constexpr size_t WS_END = WS_PART + 16 * MiB;

__device__ __forceinline__ float bflo(unsigned u) { return __uint_as_float(u << 16); }
__device__ __forceinline__ float bfhi(unsigned u) { return __uint_as_float(u & 0xffff0000u); }
__device__ __forceinline__ unsigned pk(float lo, float hi) { return pg8::cvt_pk_bf16(lo, hi); }
__device__ __forceinline__ float wave_sum(float v) {
    v += __builtin_bit_cast(float, __builtin_amdgcn_update_dpp(0, __builtin_bit_cast(int, v), 0x111, 0xf, 0xf, true));
    v += __builtin_bit_cast(float, __builtin_amdgcn_update_dpp(0, __builtin_bit_cast(int, v), 0x112, 0xf, 0xf, true));
    v += __builtin_bit_cast(float, __builtin_amdgcn_update_dpp(0, __builtin_bit_cast(int, v), 0x114, 0xf, 0xf, true));
    v += __builtin_bit_cast(float, __builtin_amdgcn_update_dpp(0, __builtin_bit_cast(int, v), 0x118, 0xf, 0xf, true));
    v += __builtin_bit_cast(float, __builtin_amdgcn_update_dpp(0, __builtin_bit_cast(int, v), 0x142, 0xa, 0xf, false));
    v += __builtin_bit_cast(float, __builtin_amdgcn_update_dpp(0, __builtin_bit_cast(int, v), 0x143, 0xc, 0xf, false));
    return __builtin_bit_cast(float, __builtin_amdgcn_readlane(__builtin_bit_cast(int, v), 63));
}
__device__ __forceinline__ float fast_sigmoid(float x) { return __builtin_amdgcn_rcpf(1.0f + __builtin_amdgcn_exp2f(-x * LOG2E)); }

struct EpiSwiGLU {
    static constexpr bool PERM = true, AFTER_DRAIN = false;
    bf16* O; const LAS float* rtab; int rowbase;
    __device__ __forceinline__ void operator()(const f32x4 (&acc)[2][2][4][2], const pg8::Unit& u, int wr, int wc, int fr, int fq) const {
        const int row0 = u.pm * 256 + wr * 64 + fr, col0 = u.pn * 128 + wc * 32 + 8 * fq;
        float rr[8];
#pragma unroll
        for (int k = 0; k < 8; ++k) rr[k] = rtab[(row0 + (k >> 2) * 128 + (k & 3) * 16 - rowbase) & 2047];
#pragma unroll
        for (int ai = 0; ai < 2; ++ai)
#pragma unroll
            for (int m = 0; m < 4; ++m) {
                const int row = row0 + ai * 128 + m * 16;
                const float r = rr[ai * 4 + m], nrl = -r * LOG2E, r2 = r * r;
                typedef float f2 __attribute__((ext_vector_type(2)));
                f2 e[4], gu[4];
#pragma unroll
                for (int k = 0; k < 4; ++k) {
                    const f2 g = {acc[ai][0][m][k >> 1][2 * (k & 1)], acc[ai][0][m][k >> 1][2 * (k & 1) + 1]}, uu = {acc[ai][1][m][k >> 1][2 * (k & 1)], acc[ai][1][m][k >> 1][2 * (k & 1) + 1]};
                    const f2 t = g * nrl; gu[k] = (g * uu) * r2;
                    e[k].x = __builtin_amdgcn_exp2f(t.x); e[k].y = __builtin_amdgcn_exp2f(t.y);
                }
#pragma unroll
                for (int k = 0; k < 4; ++k) { e[k] = e[k] + 1.0f; e[k].x = __builtin_amdgcn_rcpf(e[k].x); e[k].y = __builtin_amdgcn_rcpf(e[k].y); gu[k] = gu[k] * e[k]; }
                v4u w; w.x = pk(gu[0].x, gu[0].y); w.y = pk(gu[1].x, gu[1].y); w.z = pk(gu[2].x, gu[2].y); w.w = pk(gu[3].x, gu[3].y);
                *(v4u*)(O + (size_t)row * FF + col0) = w;
            }
    }
};
struct EpiResid {
    static constexpr bool PERM = true, AFTER_DRAIN = false;
    bf16* xb; float* part_out; float scale;
    __device__ __forceinline__ void operator()(const f32x4 (&acc)[2][2][4][2], const pg8::Unit& u, int wr, int wc, int fr, int fq) const {
        const int row0 = u.pm * 256 + wr * 64 + fr, col0 = u.pn * 256 + wc * 32 + 8 * fq;
#pragma unroll
        for (int ai = 0; ai < 2; ++ai) {
            v4u bs[4][2];
#pragma unroll
            for (int m = 0; m < 4; ++m)
#pragma unroll
                for (int bj = 0; bj < 2; ++bj) bs[m][bj] = *(const v4u*)(xb + (size_t)(row0 + ai * 128 + m * 16) * D + col0 + bj * 128);
#pragma unroll
            for (int m = 0; m < 4; ++m) {
                const int row = row0 + ai * 128 + m * 16; float sq = 0.f;
#pragma unroll
                for (int bj = 0; bj < 2; ++bj) {
                    const size_t off = (size_t)row * D + col0 + bj * 128;
                    const v4u b = bs[m][bj];
                    const f32x4 b0 = {bflo(b.x), bfhi(b.x), bflo(b.y), bfhi(b.y)}, b1 = {bflo(b.z), bfhi(b.z), bflo(b.w), bfhi(b.w)};
                    const f32x4 x0 = b0 + acc[ai][bj][m][0] * scale, x1 = b1 + acc[ai][bj][m][1] * scale;
                    v4u w; w.x = pk(x0[0], x0[1]); w.y = pk(x0[2], x0[3]); w.z = pk(x1[0], x1[1]); w.w = pk(x1[2], x1[3]);
                    *(v4u*)(xb + off) = w;
                    sq += (x0[0] * x0[0] + x0[1] * x0[1]) + (x0[2] * x0[2] + x0[3] * x0[3]) + (x1[0] * x1[0] + x1[1] * x1[1]) + (x1[2] * x1[2] + x1[3] * x1[3]);
                }
                sq += __shfl_xor(sq, 16); sq += __shfl_xor(sq, 32);
                if (fq == 0) part_out[(size_t)row * 32 + u.pn * 4 + wc] = sq;
            }
            asm volatile("" ::: "memory");
        }
    }
};
struct EpiMixIn {
    static constexpr bool PERM = true, AFTER_DRAIN = false;
    bf16* P; const LAS float* rtab; int rowbase; const float* cs;
    __device__ __forceinline__ void operator()(const f32x4 (&acc)[2][2][4][2], const pg8::Unit& u, int wr, int wc, int fr, int fq) const {
        const int row0 = u.pm * 256 + wr * 64 + fr, pn = u.pn, lc = wc * 32 + 8 * fq;
        float rr[8];
#pragma unroll
        for (int k = 0; k < 8; ++k) rr[k] = rtab[(row0 + (k >> 2) * 128 + (k & 3) * 16 - rowbase) & 2047];
#pragma unroll
        for (int ai = 0; ai < 2; ++ai)
#pragma unroll
            for (int m = 0; m < 4; ++m) {
                const int row = row0 + ai * 128 + m * 16;
                const float r = rr[ai * 4 + m];
                f32x4 a0 = acc[ai][0][m][0] * r, a1 = acc[ai][0][m][1] * r, b0 = acc[ai][1][m][0] * r, b1 = acc[ai][1][m][1] * r;
                bf16* prow = P + (size_t)row * PW;
                if (pn >= 6 && pn < 10) {
                    float o[8];
#pragma unroll
                    for (int i = 0; i < 4; ++i) { o[i] = a0[i] * fast_sigmoid(b0[i]); o[4 + i] = a1[i] * fast_sigmoid(b1[i]); }
                    v4u w; w.x = pk(o[0], o[1]); w.y = pk(o[2], o[3]); w.z = pk(o[4], o[5]); w.w = pk(o[6], o[7]);
                    *(v4u*)(prow + 1536 + 128 * (pn - 6) + lc) = w;
                } else {
                    if (pn < 5) {
                        if ((wc & 1) == 0) {
                            f32x4 pa0, pa1, pb0, pb1;
#pragma unroll
                            for (int i = 0; i < 4; ++i) { pa0[i] = __shfl_xor(a0[i], 16); pa1[i] = __shfl_xor(a1[i], 16); pb0[i] = __shfl_xor(b0[i], 16); pb1[i] = __shfl_xor(b1[i], 16); }
                            if (fq < 2) {
                                const float* c = cs + (size_t)row * 16;
                                const f32x4 c0 = *(const f32x4*)c, c1 = *(const f32x4*)(c + 4); f32x4 s0 = *(const f32x4*)(c + 8), s1 = *(const f32x4*)(c + 12);
                                if (fq == 0) { s0 = -s0; s1 = -s1; }
                                a0 = a0 * c0 + pa0 * s0; a1 = a1 * c1 + pa1 * s1; b0 = b0 * c0 + pb0 * s0; b1 = b1 * c1 + pb1 * s1;
                            }
                        }
                        if (pn < 4) { a0 = a0 * 0.125f; a1 = a1 * 0.125f; b0 = b0 * 0.125f; b1 = b1 * 0.125f; }
                    }
                    const int cb = (pn <= 5 ? 256 * pn : 256 * pn - 512) + lc;
                    v4u w; w.x = pk(a0[0], a0[1]); w.y = pk(a0[2], a0[3]); w.z = pk(a1[0], a1[1]); w.w = pk(a1[2], a1[3]);
                    *(v4u*)(prow + cb) = w;
                    v4u z; z.x = pk(b0[0], b0[1]); z.y = pk(b0[2], b0[3]); z.z = pk(b1[0], b1[1]); z.w = pk(b1[2], b1[3]);
                    *(v4u*)(prow + cb + 128) = z;
                }
                if (m & 1) asm volatile("" ::: "memory");
            }
    }
};

__device__ __forceinline__ void transpose_item(const float* W, int K, int N, const float* g, bf16* WT, int k0, int n0, int sn0, LAS unsigned* scr, int lane) {
    const int c4 = lane & 31, ph = lane >> 5;
    const float* src = W + (size_t)(k0 + 2 * ph) * N + sn0 + 4 * c4;
    f32x4 ra[16], rb[16];
#pragma unroll
    for (int i = 0; i < 16; ++i) { ra[i] = *(const f32x4*)(src + (size_t)(4 * i) * N); rb[i] = *(const f32x4*)(src + (size_t)(4 * i + 1) * N); }
#pragma unroll
    for (int i = 0; i < 16; ++i) {
        const int p = ph + 2 * i;
        float ga = 1.f, gb = 1.f; if (g) { ga = g[k0 + 2 * p]; gb = g[k0 + 2 * p + 1]; }
        LAS unsigned* d = scr + p * 129 + c4;
        d[0] = pk(ra[i][0] * ga, rb[i][0] * gb); d[32] = pk(ra[i][1] * ga, rb[i][1] * gb); d[64] = pk(ra[i][2] * ga, rb[i][2] * gb); d[96] = pk(ra[i][3] * ga, rb[i][3] * gb);
    }
    asm volatile("s_waitcnt lgkmcnt(0)" ::: "memory");
    const int c = lane & 7, q = lane >> 3;
#pragma unroll
    for (int j = 0; j < 16; ++j) {
        const int n = 4 * ((q & 3) + 4 * (j >> 1)) + ((q >> 2) + 2 * (j & 1));
        const LAS unsigned* sp = scr + (4 * c) * 129 + (n & 3) * 32 + (n >> 2);
        v4u o; o.x = sp[0]; o.y = sp[129]; o.z = sp[258]; o.w = sp[387];
        *(v4u*)(WT + ((size_t)(k0 >> 6) * N + (n0 + n)) * 64 + 8 * c) = o;
    }
    asm volatile("s_waitcnt lgkmcnt(0)" ::: "memory");
}
__device__ __forceinline__ int src_col(int mode, int n0) {
    if (mode == 1) return ((n0 >> 7) & 1) * FF + 128 * (n0 >> 8) + (n0 & 127);
    if (mode == 2) { const int pn = n0 >> 8; if (pn >= 6 && pn < 10) return 1536 + 512 * ((n0 >> 7) & 1) + 128 * (pn - 6) + (n0 & 127); }
    return n0;
}
__device__ __forceinline__ void convert_matrix(const float* W, int K, int N, const float* g, bf16* WT, int mode, int item, LAS unsigned* scr, int lane) {
    const int nblk = N / 128, kb = item / nblk, nb = item % nblk;
    transpose_item(W, K, N, g, WT, 64 * kb, 128 * nb, src_col(mode, 128 * nb), scr, lane);
}

struct Args {
    const float* x; const int* pos;
    const float *norm_ffn1, *ffn1_w_in, *ffn1_w_out, *norm_mix, *w_in, *conv_dw_w, *conv_dw_b, *conv_ln_g, *conv_ln_b, *sgu_ln_g, *sgu_ln_b, *sgu_w, *sgu_b, *attn_sinks, *w_out,
        *norm_ffn2, *ffn2_w_in, *ffn2_w_out, *final_norm;
    float* out; unsigned char* ws;
};

__device__ __forceinline__ void prologue(const Args& a, ldsp lds, int gw, int NGW, int lane, int wave) {
    LAS unsigned* scr = (LAS unsigned*)(lds + wave * 16640);
    constexpr int I_FI = (D / 64) * (NFF / 128), I_FO = (FF / 64) * (D / 128), I_IN = (D / 64) * (NIN / 128), I_OUT = (D / 64) * (D / 128);
    constexpr int I_LAYER = 2 * I_FI + 2 * I_FO + I_IN + I_OUT;
    for (int it = gw; it < 2 * I_LAYER; it += NGW) {
        const int l = it / I_LAYER; int r = it % I_LAYER;
        unsigned char* wl = a.ws + WS_W + (size_t)l * WL_SIZE;
        if (r < I_FI) { convert_matrix(a.ffn1_w_in + (size_t)l * D * NFF, D, NFF, a.norm_ffn1 + l * D, (bf16*)(wl + WL_F1I), 1, r, scr, lane); continue; } r -= I_FI;
        if (r < I_FI) { convert_matrix(a.ffn2_w_in + (size_t)l * D * NFF, D, NFF, a.norm_ffn2 + l * D, (bf16*)(wl + WL_F2I), 1, r, scr, lane); continue; } r -= I_FI;
        if (r < I_IN) { convert_matrix(a.w_in + (size_t)l * D * NIN, D, NIN, a.norm_mix + l * D, (bf16*)(wl + WL_IN), 2, r, scr, lane); continue; } r -= I_IN;
        if (r < I_FO) { convert_matrix(a.ffn1_w_out + (size_t)l * FF * D, FF, D, nullptr, (bf16*)(wl + WL_F1O), 0, r, scr, lane); continue; } r -= I_FO;
        if (r < I_FO) { convert_matrix(a.ffn2_w_out + (size_t)l * FF * D, FF, D, nullptr, (bf16*)(wl + WL_F2O), 0, r, scr, lane); continue; } r -= I_FO;
        convert_matrix(a.w_out + (size_t)l * D * D, D, D, nullptr, (bf16*)(wl + WL_OUT), 0, r, scr, lane);
    }
}

__device__ __forceinline__ void prologue_rows(const Args& a, int gw, int NGW, int lane, int gtid, int NGT) {
    bf16* XB = (bf16*)(a.ws + WS_XB); float* part0 = (float*)(a.ws + WS_PART);
    for (int m = gw; m < M; m += NGW) {
        const f32x4* xr = (const f32x4*)(a.x + (size_t)m * D) + lane; v2u* o8 = (v2u*)(XB + (size_t)m * D) + lane; float s = 0.f;
#pragma unroll
        for (int j = 0; j < 8; ++j) { const f32x4 v = xr[64 * j]; s += (v[0] * v[0] + v[1] * v[1]) + (v[2] * v[2] + v[3] * v[3]); v2u w; w.x = pk(v[0], v[1]); w.y = pk(v[2], v[3]); o8[64 * j] = w; }
        s = wave_sum(s);
        if (lane < 32) part0[(size_t)m * 32 + lane] = (lane == 0) ? s : 0.f;
    }
    float* cs = (float*)(a.ws + WS_CS);
    for (int i = gtid; i < M * 8; i += NGT) {
        const int m = i >> 3, f = i & 7;
        const float invf[8] = {1.0f, 0.193922758102417f, 0.03760603070259094f, 0.00729266507551074f, 0.001414213445968926f, 0.00027424818836152554f, 5.318296462064609e-05f, 1.0313385246263351e-05f};
        float fr_ = invf[0];
#pragma unroll
        for (int k = 1; k < 8; ++k) fr_ = (f == k) ? invf[k] : fr_;
        const float ang = (float)a.pos[m] * fr_;
        double t = (double)ang * 0.15915494309189533577; t -= __builtin_rint(t);
        const float tf = (float)t;
        cs[(size_t)m * 16 + f] = __builtin_amdgcn_cosf(tf); cs[(size_t)m * 16 + 8 + f] = __builtin_amdgcn_sinf(tf);
    }
}

#define MFMA16(a, b, c) __builtin_amdgcn_mfma_f32_16x16x32_bf16(a, b, c, 0, 0, 0)

__device__ __forceinline__ void attn_unit(ldsp lds, const bf16* P, bf16* MX, const float* sinks, int b, int n, int g, int tid) {
    const int lane = tid & 63, wid = tid >> 6, fr = lane & 15, fq = lane >> 4;
    ldsp Kl = lds; ldsp Vl = lds + 36864;
    const int tok0 = b * SEQ + n * 128;
    const int hq = 4 * g + (wid >> 1), half = wid & 1;
    v4u kvr[4], vvr[4];
#pragma unroll
    for (int i = 0; i < 4; ++i) {
        const int p = tid + 512 * i, key = p >> 3, ch = p & 7;
        kvr[i] = (v4u){0u, 0u, 0u, 0u}; vvr[i] = (v4u){0u, 0u, 0u, 0u};
        if (n > 0 || key >= 128) { const bf16* src = P + (size_t)(tok0 - 128 + key) * PW + 64 * g + 8 * ch; kvr[i] = *(const v4u*)(src + 1024); vvr[i] = *(const v4u*)(src + 1280); }
    }
    const bf16* qbase = P + (size_t)(tok0 + 64 * half + fr) * PW + 64 * hq + 8 * fq;
    bf16x8 qn0 = *(const bf16x8*)qbase, qn1 = *(const bf16x8*)(qbase + 32);
    const float sink = sinks[hq];
#pragma unroll
    for (int i = 0; i < 4; ++i) {
        const int p = tid + 512 * i, key = p >> 3, ch = p & 7;
        *(LAS v4u*)(Kl + key * 144 + ch * 16) = kvr[i];
#pragma unroll
        for (int j = 0; j < 8; ++j) { const unsigned e = (vvr[i][j >> 1] >> (16 * (j & 1))) & 0xffffu; *(LAS unsigned short*)(Vl + (8 * ch + j) * 528 + key * 2) = (unsigned short)e; }
    }
    __syncthreads();
#pragma unroll 1
    for (int mt = 0; mt < 4; ++mt) {
        const int mp = 4 * half + mt;
        const bf16x8 q0 = qn0, q1 = qn1;
        { const bf16* qnx = qbase + (size_t)(16 * (mt < 3 ? mt + 1 : 3)) * PW; qn0 = *(const bf16x8*)qnx; qn1 = *(const bf16x8*)(qnx + 32); }
        f32x4 s[9];
#pragma unroll
        for (int kt = 0; kt < 9; ++kt) {
            ldsp kp = Kl + (16 * (mp + kt) + fr) * 144 + fq * 16;
            const bf16x8 k0 = *(const LAS bf16x8*)kp, k1 = *(const LAS bf16x8*)(kp + 64);
            f32x4 z = {0.f, 0.f, 0.f, 0.f};
            z = MFMA16(k0, q0, z); z = MFMA16(k1, q1, z); s[kt] = z;
        }
#pragma unroll
        for (int i = 0; i < 4; ++i) { if (!(4 * fq + i > fr)) s[0][i] = -1e30f; if (!(4 * fq + i <= fr)) s[8][i] = -1e30f; }
        if (n == 0) {
#pragma unroll
            for (int kt = 0; kt < 8; ++kt) if (mp + kt < 8) s[kt] = (f32x4){-1e30f, -1e30f, -1e30f, -1e30f};
        }
        float mx = sink;
#pragma unroll
        for (int kt = 0; kt < 9; ++kt) mx = fmaxf(mx, fmaxf(fmaxf(s[kt][0], s[kt][1]), fmaxf(s[kt][2], s[kt][3])));
        mx = fmaxf(mx, __shfl_xor(mx, 16)); mx = fmaxf(mx, __shfl_xor(mx, 32));
        float sum = 0.f; const float mxl = mx * LOG2E;
#pragma unroll
        for (int kt = 0; kt < 9; ++kt)
#pragma unroll
            for (int i = 0; i < 4; ++i) { const float p = __builtin_amdgcn_exp2f(s[kt][i] * LOG2E - mxl); s[kt][i] = p; sum += p; }
        sum += __shfl_xor(sum, 16); sum += __shfl_xor(sum, 32);
        sum += __builtin_amdgcn_exp2f(sink * LOG2E - mxl);
        const float inv = 1.0f / sum;
        f32x4 o[4];
#pragma unroll
        for (int nd = 0; nd < 4; ++nd) o[nd] = (f32x4){0.f, 0.f, 0.f, 0.f};
#pragma unroll
        for (int sp = 0; sp < 5; ++sp) {
            const int tA = mp + 2 * sp, tB = (sp < 4) ? tA + 1 : tA;
            v4u pw; pw.x = pk(s[2 * sp][0], s[2 * sp][1]); pw.y = pk(s[2 * sp][2], s[2 * sp][3]);
            const int iB = (sp < 4) ? 2 * sp + 1 : 8;
            if (sp < 4) { pw.z = pk(s[iB][0], s[iB][1]); pw.w = pk(s[iB][2], s[iB][3]); } else { pw.z = 0u; pw.w = 0u; }
            const bf16x8 pf = __builtin_bit_cast(bf16x8, pw);
#pragma unroll
            for (int nd = 0; nd < 4; ++nd) {
                ldsp vr = Vl + (16 * nd + fr) * 528 + 8 * fq;
                v4u vw; const v2u va = *(const LAS v2u*)(vr + 32 * tA), vb = *(const LAS v2u*)(vr + 32 * tB);
                vw.x = va.x; vw.y = va.y; vw.z = vb.x; vw.w = vb.y;
                o[nd] = MFMA16(__builtin_bit_cast(bf16x8, vw), pf, o[nd]);
            }
        }
        bf16* orow = MX + (size_t)(tok0 + 16 * mp + fr) * D + 64 * hq + 4 * fq;
#pragma unroll
        for (int nd = 0; nd < 4; ++nd) { v2u w; w.x = pk(o[nd][0] * inv, o[nd][1] * inv); w.y = pk(o[nd][2] * inv, o[nd][3] * inv); *(v2u*)(orow + 16 * nd) = w; }
    }
    __syncthreads();
}

typedef float f32x2 __attribute__((ext_vector_type(2)));
__device__ __forceinline__ void conv_unit(ldsp lds, const bf16* P, bf16* MX, const float* dw_w, const float* dw_b, const float* ln_g, const float* ln_b, int cu, int tid) {
    const int lane = tid & 63, wid = tid >> 6;
    const int tok0 = 32 * cu, s0 = tok0 & (SEQ - 1);
    ldsp Wl = lds + 65536;
    v4u st[8]; f32x4 sw[8];
#pragma unroll
    for (int i = 0; i < 8; ++i) {
        const int p = tid + NTHREADS * i, r = p >> 6, c = p & 63; st[i] = (v4u){0u, 0u, 0u, 0u};
        if (p < 3968 && s0 - 30 + r >= 0) st[i] = *(const v4u*)(P + (size_t)(tok0 - 30 + r) * PW + 1536 + 8 * c);
        sw[i] = (f32x4){0.f, 0.f, 0.f, 0.f};
        if (p < 3968) sw[i] = *(const f32x4*)(dw_w + 4 * p);
    }
#pragma unroll
    for (int i = 0; i < 8; ++i) {
        const int p = tid + NTHREADS * i, r = p >> 6, c = p & 63;
        if (p < 3968) { *(LAS v4u*)(lds + r * 1040 + c * 16) = st[i]; *(LAS f32x4*)(Wl + p * 16) = sw[i]; }
    }
    __syncthreads();
    const int c0 = 8 * lane;
    f32x2 acc[4][4];
#pragma unroll
    for (int t = 0; t < 4; ++t)
#pragma unroll
        for (int k = 0; k < 4; ++k) acc[t][k] = (f32x2){0.f, 0.f};
    ldsp rb = lds + (4 * wid) * 1040 + lane * 16; ldsp wb = Wl + lane * 32;
#pragma unroll 1
    for (int j = 0; j < 31; ++j) {
        const f32x4 w0 = *(const LAS f32x4*)(wb + j * 2048), w1 = *(const LAS f32x4*)(wb + j * 2048 + 16);
        const f32x2 wv[4] = {{w0[0], w0[1]}, {w0[2], w0[3]}, {w1[0], w1[1]}, {w1[2], w1[3]}};
#pragma unroll
        for (int t = 0; t < 4; ++t) {
            const v4u hv = *(const LAS v4u*)(rb + (t + j) * 1040);
#pragma unroll
            for (int k = 0; k < 4; ++k) { const f32x2 h2 = {bflo(hv[k]), bfhi(hv[k])}; acc[t][k] += h2 * wv[k]; }
        }
    }
    const f32x4 bb0 = *(const f32x4*)(dw_b + c0), bb1 = *(const f32x4*)(dw_b + c0 + 4), g0 = *(const f32x4*)(ln_g + c0), g1 = *(const f32x4*)(ln_g + c0 + 4), e0 = *(const f32x4*)(ln_b + c0), e1 = *(const f32x4*)(ln_b + c0 + 4);
#pragma unroll
    for (int t = 0; t < 4; ++t) {
        f32x4 y0 = (f32x4){acc[t][0][0], acc[t][0][1], acc[t][1][0], acc[t][1][1]} + bb0, y1 = (f32x4){acc[t][2][0], acc[t][2][1], acc[t][3][0], acc[t][3][1]} + bb1;
        const float s = (y0[0] + y0[1]) + (y0[2] + y0[3]) + (y1[0] + y1[1]) + (y1[2] + y1[3]);
        const float mean = wave_sum(s) * (1.0f / 512.0f);
        y0 = y0 - mean; y1 = y1 - mean;
        const float q = (y0[0] * y0[0] + y0[1] * y0[1]) + (y0[2] * y0[2] + y0[3] * y0[3]) + (y1[0] * y1[0] + y1[1] * y1[1]) + (y1[2] * y1[2] + y1[3] * y1[3]);
        const float rstd = __builtin_amdgcn_rsqf(wave_sum(q) * (1.0f / 512.0f) + EPS);
        y0 = y0 * rstd * g0 + e0; y1 = y1 * rstd * g1 + e1;
#pragma unroll
        for (int c = 0; c < 4; ++c) { y0[c] = y0[c] * fast_sigmoid(y0[c]); y1[c] = y1[c] * fast_sigmoid(y1[c]); }
        v4u w; w.x = pk(y0[0], y0[1]); w.y = pk(y0[2], y0[3]); w.z = pk(y1[0], y1[1]); w.w = pk(y1[2], y1[3]);
        *(v4u*)(MX + (size_t)(tok0 + 4 * wid + t) * D + 1024 + c0) = w;
    }
    __syncthreads();
}

__device__ __forceinline__ void sgu_unit(ldsp lds, const bf16* P, bf16* MX, const float* ln_g, const float* ln_b, const float* w_s, const float* b_s, int ck, int hf, int tid) {
    const int lane = tid & 63, wid = tid >> 6, fr = lane & 15, fq = lane >> 4;
    const int tok0 = 128 * ck, c0 = 8 * lane;
    const int hl = wid >> 1, hh = 4 * hf + hl, th = wid & 1;
    {
        const f32x4 g0 = *(const f32x4*)(ln_g + c0), g1 = *(const f32x4*)(ln_g + c0 + 4), e0 = *(const f32x4*)(ln_b + c0), e1 = *(const f32x4*)(ln_b + c0 + 4);
#pragma unroll 1
        for (int i4 = 0; i4 < 16; i4 += 4) {
        v4u raw4[4];
#pragma unroll
        for (int i = 0; i < 4; ++i) raw4[i] = *(const v4u*)(P + (size_t)(tok0 + 16 * wid + i4 + i) * PW + 2560 + c0);
#pragma unroll
        for (int i = 0; i < 4; ++i) {
            const int sidx = 16 * wid + i4 + i; const v4u rw = raw4[i];
            float v[8] = {bflo(rw.x), bfhi(rw.x), bflo(rw.y), bfhi(rw.y), bflo(rw.z), bfhi(rw.z), bflo(rw.w), bfhi(rw.w)};
            float s = 0.f;
#pragma unroll
            for (int c = 0; c < 8; ++c) s += v[c];
            const float mean = wave_sum(s) * (1.0f / 512.0f); float q = 0.f;
#pragma unroll
            for (int c = 0; c < 8; ++c) { v[c] -= mean; q += v[c] * v[c]; }
            const float rstd = __builtin_amdgcn_rsqf(wave_sum(q) * (1.0f / 512.0f) + EPS);
            if ((lane >> 5) == hf) {
#pragma unroll
                for (int c = 0; c < 8; ++c) { const float vn = v[c] * rstd * (c < 4 ? g0[c & 3] : g1[c & 3]) + (c < 4 ? e0[c & 3] : e1[c & 3]);
                    *(LAS unsigned short*)(lds + ((c0 & 255) + c) * 272 + 2 * sidx) = (unsigned short)(pk(vn, 0.f) & 0xffffu); }
            }
        }
        }
    }
    __syncthreads();
#pragma unroll 1
    for (int m = 0; m < 4; ++m) {
        const int t0 = 64 * th + 16 * m, t = t0 + fr;
        f32x4 acc[4];
#pragma unroll
        for (int nd = 0; nd < 4; ++nd) acc[nd] = (f32x4){0.f, 0.f, 0.f, 0.f};
        const float* wrow = w_s + ((size_t)hh * 128 + t) * 128;
        const int nks = (t0 + 15) / 32 + 1;
        f32x4 wa[4], wb[4];
#pragma unroll
        for (int ks = 0; ks < 4; ++ks) { const int kk = ks < nks ? ks : 0; wa[ks] = *(const f32x4*)(wrow + 32 * kk + 8 * fq); wb[ks] = *(const f32x4*)(wrow + 32 * kk + 8 * fq + 4); }
        const float bias = b_s[hh * 128 + t];
        v2u uu[4];
#pragma unroll
        for (int nd = 0; nd < 4; ++nd) uu[nd] = *(const v2u*)(P + (size_t)(tok0 + t) * PW + 2048 + 64 * hh + 16 * nd + 4 * fq);
#pragma unroll
        for (int ks = 0; ks < 4; ++ks) {
            if (ks < nks) {
                const int sb = 32 * ks + 8 * fq;
                f32x4 xa = wa[ks], xb = wb[ks];
#pragma unroll
                for (int i = 0; i < 4; ++i) { xa[i] = (sb + i <= t) ? xa[i] : 0.f; xb[i] = (sb + 4 + i <= t) ? xb[i] : 0.f; }
                v4u ww; ww.x = pk(xa[0], xa[1]); ww.y = pk(xa[2], xa[3]); ww.z = pk(xb[0], xb[1]); ww.w = pk(xb[2], xb[3]);
                const bf16x8 wf = __builtin_bit_cast(bf16x8, ww);
#pragma unroll
                for (int nd = 0; nd < 4; ++nd) {
                    const bf16x8 vf = *(const LAS bf16x8*)(lds + (64 * hl + 16 * nd + fr) * 272 + 64 * ks + 16 * fq);
                    acc[nd] = MFMA16(vf, wf, acc[nd]);
                }
            }
        }
#pragma unroll
        for (int nd = 0; nd < 4; ++nd) {
            const int ch = 64 * hh + 16 * nd + 4 * fq;
            v2u w; w.x = pk((acc[nd][0] + bias) * bflo(uu[nd].x), (acc[nd][1] + bias) * bfhi(uu[nd].x)); w.y = pk((acc[nd][2] + bias) * bflo(uu[nd].y), (acc[nd][3] + bias) * bfhi(uu[nd].y));
            *(v2u*)(MX + (size_t)(tok0 + t) * D + 1536 + ch) = w;
        }
    }
    __syncthreads();
}

#define XB_TMO      128
#define XB_XCNT(j)  (256  + 64 * (j))
#define XB_XSUB(j)  (1280 + 64 * (j))
#define XB_XGEN(j)  (2304 + 64 * (j))
#define XB_TOP      3328
#define XB_TOPGEN   3392
#define XCD_BAR_WORDS 3456
#define XB_SPIN_CAP (1u << 23)

__device__ __forceinline__ unsigned xb_ld(unsigned* p)              { return __hip_atomic_load(p, __ATOMIC_RELAXED, __HIP_MEMORY_SCOPE_AGENT); }
__device__ __forceinline__ unsigned xb_add(unsigned* p, unsigned v) { return __hip_atomic_fetch_add(p, v, __ATOMIC_RELAXED, __HIP_MEMORY_SCOPE_AGENT); }
__device__ __forceinline__ unsigned xb_xcc_id() { return (unsigned)__builtin_amdgcn_s_getreg((3 << 11) | 20) & 0xFu; }
#define XB_SPIN(cond, bar) do { unsigned _sp = 0; while (cond) { __builtin_amdgcn_s_sleep(1); \
    if ((++_sp & 255u) == 0u) { if (xb_ld(&(bar)[XB_TMO])) break; if (_sp > XB_SPIN_CAP) { atomicAdd(&(bar)[XB_TMO], 1u); break; } } } } while (0)

struct XcdBarrier {
    unsigned* bar; unsigned x;
    volatile LAS unsigned* st;
};

__device__ __forceinline__ XcdBarrier xcd_barrier_post(unsigned* bar, volatile LAS unsigned* st) {
    XcdBarrier b; b.bar = bar; b.x = xb_xcc_id(); b.st = st;
    if (threadIdx.x == 0) (void)xb_add(&bar[XB_XCNT(b.x)], 1u);
    return b;
}
__device__ __forceinline__ void xcd_barrier_complete(unsigned* bar, unsigned x, unsigned& nloc, unsigned& nx) {
    const unsigned G = gridDim.x * gridDim.y * gridDim.z;
    unsigned sum, cnt, mine, sp = 0u;
    for (;;) {
        sum = 0u; cnt = 0u; mine = 0u;
#pragma unroll
        for (unsigned j = 0; j < 16; ++j) { const unsigned c = xb_ld(&bar[XB_XCNT(j)]); sum += c; cnt += (c > 0u) ? 1u : 0u; mine = (j == x) ? c : mine; }
        if (sum == G) break;
        __builtin_amdgcn_s_sleep(1);
        if ((++sp & 255u) == 0u) { if (xb_ld(&bar[XB_TMO])) break; if (sp > XB_SPIN_CAP) { atomicAdd(&bar[XB_TMO], 1u); break; } }
    }
    nloc = mine > 0u ? mine : 1u; nx = cnt > 0u ? cnt : 1u;
}

__device__ __forceinline__ void xcd_barrier(const XcdBarrier& b) {
    asm volatile("s_waitcnt vmcnt(0)" ::: "memory");
    __syncthreads();
    if (threadIdx.x == 0) {
        unsigned* bar = b.bar;
        __builtin_amdgcn_s_waitcnt(0);
        unsigned nloc = b.st[0], nx = b.st[1];
        if (nloc == 0u) { xcd_barrier_complete(bar, b.x, nloc, nx); b.st[0] = nloc; b.st[1] = nx; }
        const unsigned old = xb_add(&bar[XB_XSUB(b.x)], 1u);
        const unsigned gen = old / nloc;
        if (old + 1u == (gen + 1u) * nloc) {
            __builtin_amdgcn_fence(__ATOMIC_RELEASE, "agent");
            asm volatile("s_waitcnt vmcnt(0)" ::: "memory");
            const unsigned og = xb_add(&bar[XB_TOP], 1u);
            const unsigned tg = og / nx;
            if (og + 1u == (tg + 1u) * nx) xb_add(&bar[XB_TOPGEN], 1u);
            else XB_SPIN(xb_ld(&bar[XB_TOPGEN]) == tg, bar);
            __builtin_amdgcn_fence(__ATOMIC_ACQUIRE, "agent");
            xb_add(&bar[XB_XGEN(b.x)], 1u);
            asm volatile("s_waitcnt vmcnt(0)" ::: "memory");
        } else {
            XB_SPIN(xb_ld(&bar[XB_XGEN(b.x)]) == gen, bar);
            __builtin_amdgcn_fence(__ATOMIC_ACQUIRE, "agent");
            asm volatile("s_waitcnt vmcnt(0)" ::: "memory");
        }
    }
    __syncthreads();
}

__device__ __forceinline__ void build_rtab(LAS float* rtab, const float* part, int rowbase, int tid) {
#pragma unroll 1
    for (int i = tid; i < 2048; i += NTHREADS) {
        const f32x4* p = (const f32x4*)(part + (size_t)(rowbase + i) * 32);
        f32x4 v[8];
#pragma unroll
        for (int k = 0; k < 8; ++k) v[k] = p[k];
        float s = 0.f;
#pragma unroll
        for (int k = 0; k < 8; ++k) s += (v[k][0] + v[k][1]) + (v[k][2] + v[k][3]);
        rtab[i] = __builtin_amdgcn_rsqf(s * (1.0f / D) + EPS);
    }
    __syncthreads();
}

typedef const __attribute__((address_space(4))) Args* kargp;
__device__ __forceinline__ kargp kargs() { kargp p = (kargp)__builtin_amdgcn_kernarg_segment_ptr(); asm volatile("" : "+s"(p)); return p; }
__global__ void __launch_bounds__(NTHREADS, 2) fwd_megakernel(Args a_unused) {
    extern __shared__ __attribute__((aligned(16))) unsigned char lds_raw[];
    cg::grid_group grid = cg::this_grid();
    ldsp lds = (ldsp)lds_raw;
    const int tid = threadIdx.x, lane = tid & 63, wave = __builtin_amdgcn_readfirstlane(tid >> 6);
    const int G = gridDim.x, bid = blockIdx.x;
    const int gw = bid * NWAVES + wave, NGW = G * NWAVES, gtid = bid * NTHREADS + tid, NGT = G * NTHREADS;
    unsigned char* ws = kargs()->ws;

#ifndef PROBE_PRO
#define PROBE_PRO 1
#endif
#ifndef PROBE_MIX
#define PROBE_MIX 1
#endif
#ifndef PROBE_FFI
#define PROBE_FFI 1
#endif
    volatile LAS unsigned* bar_st = (volatile LAS unsigned*)(lds + LDS_BYTES - 64);
    if (tid < 2) bar_st[tid] = 0u;
    if (bid == 0) { unsigned* bw = (unsigned*)a_unused.ws; for (int i = tid; i < XCD_BAR_WORDS; i += NTHREADS) bw[i] = 0u; }
    for (int rep = 0; rep < PROBE_PRO; ++rep) prologue(a_unused, lds, gw, NGW, lane, wave);
    prologue_rows(a_unused, gw, NGW, lane, gtid, NGT);
    grid.sync();
    const XcdBarrier xbar = xcd_barrier_post((unsigned*)ws, bar_st);

    for (int step = 0; step < 6; ++step) {
        const int l = step / 3, sub = step % 3;
        ws = kargs()->ws; const unsigned char* wl = ws + WS_W + (size_t)l * WL_SIZE;
        float* partb = (float*)(ws + WS_PART); const float* cs = (const float*)(ws + WS_CS); LAS float* rtab = (LAS float*)(lds + 131072);
        bf16* XB = (bf16*)(ws + WS_XB); bf16* ACT = (bf16*)(ws + WS_ACT); bf16* PB = (bf16*)(ws + WS_P); bf16* MX = (bf16*)(ws + WS_MX);
        const float* part_in = partb + (size_t)step * M * 32; float* part_out = partb + (size_t)(step + 1) * M * 32;
        const bf16* A2; const bf16* B2; int K2; float scale;
        if (sub != 1) {
            pg8::Gemm g{XB, (const bf16*)(wl + (sub == 0 ? WL_F1I : WL_F2I)), M, NFF, D}; pg8::StaticOrder S; S.init(M, NFF, G, bid);
            pg8::Unit u0; int rowbase = 0; if (S.next(0, u0)) rowbase = (u0.pm & ~7) * 256;
            { int tl = threadIdx.x; asm volatile("" : "+v"(tl)); build_rtab(rtab, part_in, rowbase, tl); }
            EpiSwiGLU E{ACT, rtab, rowbase};
            for (int rep = 0; rep < PROBE_FFI; ++rep) pg8::gemm_phase<EpiSwiGLU, pg8::StaticOrder, true, true>(lds, g, S, E);
            xcd_barrier(xbar);
            A2 = ACT; B2 = (const bf16*)(wl + (sub == 0 ? WL_F1O : WL_F2O)); K2 = FF; scale = 0.5f;
        } else {
            {
                pg8::Gemm g{XB, (const bf16*)(wl + WL_IN), M, NIN, D}; pg8::StaticOrder S; S.init(M, NIN, G, bid);
                pg8::Unit u0; int rowbase = 0; if (S.next(0, u0)) rowbase = (u0.pm & ~7) * 256;
                { int tl = threadIdx.x; asm volatile("" : "+v"(tl)); build_rtab(rtab, part_in, rowbase, tl); }
                EpiMixIn E{PB, rtab, rowbase, cs};
                pg8::gemm_phase<EpiMixIn, pg8::StaticOrder, true, true>(lds, g, S, E);
            }
            xcd_barrier(xbar);
            for (int rep = 0; rep < PROBE_MIX; ++rep)
            for (int u = bid; u < 1280; u += G) {
                kargp a = kargs(); int tl = threadIdx.x; asm volatile("" : "+v"(tl));
                if (u < 512) attn_unit(lds, PB, MX, a->attn_sinks + l * 16, u >> 7, (u & 127) >> 2, u & 3, tl);
                else if (u < 1024) conv_unit(lds, PB, MX, a->conv_dw_w + (size_t)l * 31 * 512, a->conv_dw_b + l * 512, a->conv_ln_g + l * 512, a->conv_ln_b + l * 512, u - 512, tl);
                else sgu_unit(lds, PB, MX, a->sgu_ln_g + l * 512, a->sgu_ln_b + l * 512, a->sgu_w + (size_t)l * 8 * 128 * 128, a->sgu_b + l * 8 * 128, (u - 1024) >> 1, (u - 1024) & 1, tl);
            }
            xcd_barrier(xbar);
            A2 = MX; B2 = (const bf16*)(wl + WL_OUT); K2 = D; scale = 1.0f;
        }
        {
            pg8::Gemm g{A2, B2, M, D, K2}; pg8::StaticOrder S; S.init(M, D, G, bid);
            EpiResid E{XB, part_out, scale};
            pg8::gemm_phase<EpiResid, pg8::StaticOrder, true, true>(lds, g, S, E);
        }
        xcd_barrier(xbar);
    }
    {
        kargp a = kargs(); const float* part = (const float*)(a->ws + WS_PART) + (size_t)6 * M * 32; float* outp = a->out; const float* fng = a->final_norm; const bf16* XBf = (const bf16*)(a->ws + WS_XB);
        for (int m = gw; m < M; m += NGW) {
            const float r = __builtin_amdgcn_rsqf(wave_sum(lane < 32 ? part[(size_t)m * 32 + lane] : 0.f) * (1.0f / D) + EPS);
            const v4u* xr = (const v4u*)(XBf + (size_t)m * D) + lane; f32x4* orow = (f32x4*)(outp + (size_t)m * D); const f32x4* gr = (const f32x4*)fng;
#pragma unroll
            for (int j = 0; j < 4; ++j) {
                const v4u b = xr[64 * j]; const int c4 = 2 * (lane + 64 * j);
                const f32x4 x0 = {bflo(b.x), bfhi(b.x), bflo(b.y), bfhi(b.y)}, x1 = {bflo(b.z), bfhi(b.z), bflo(b.w), bfhi(b.w)};
                orow[c4] = x0 * r * gr[c4]; orow[c4 + 1] = x1 * r * gr[c4 + 1];
            }
        }
    }
}

extern "C" void kernel_launch(void* const* d_in, const int* in_sizes, int n_in, void* d_out, int out_size, void* d_ws, size_t ws_size, hipStream_t stream) {
    static int grid_blocks = 0;
    if (grid_blocks == 0) {
        if (n_in != 21 || out_size != M * D || ws_size < WS_END) { fprintf(stderr, "kernel_launch: unexpected shapes (n_in %d out %d ws %zu need %zu)\n", n_in, out_size, ws_size, (size_t)WS_END); grid_blocks = -1; return; }
        int dev = 0, cus = 0, per_cu = 0;
        (void)hipGetDevice(&dev);
        (void)hipDeviceGetAttribute(&cus, hipDeviceAttributeMultiprocessorCount, dev);
        if (hipFuncSetAttribute((const void*)fwd_megakernel, hipFuncAttributeMaxDynamicSharedMemorySize, LDS_BYTES) != hipSuccess) { fprintf(stderr, "kernel_launch: hipFuncSetAttribute failed\n"); grid_blocks = -1; return; }
        if (hipOccupancyMaxActiveBlocksPerMultiprocessor(&per_cu, (const void*)fwd_megakernel, NTHREADS, LDS_BYTES) != hipSuccess || per_cu < 1) { fprintf(stderr, "kernel_launch: occupancy query says %d\n", per_cu); per_cu = 1; (void)hipGetLastError(); }
        grid_blocks = cus * per_cu;
    }
    if (grid_blocks < 0) return;
    Args a{};
    a.x = (const float*)d_in[0]; a.pos = (const int*)d_in[1];
    a.norm_ffn1 = (const float*)d_in[2]; a.ffn1_w_in = (const float*)d_in[3]; a.ffn1_w_out = (const float*)d_in[4]; a.norm_mix = (const float*)d_in[5]; a.w_in = (const float*)d_in[6];
    a.conv_dw_w = (const float*)d_in[7]; a.conv_dw_b = (const float*)d_in[8]; a.conv_ln_g = (const float*)d_in[9]; a.conv_ln_b = (const float*)d_in[10];
    a.sgu_ln_g = (const float*)d_in[11]; a.sgu_ln_b = (const float*)d_in[12]; a.sgu_w = (const float*)d_in[13]; a.sgu_b = (const float*)d_in[14]; a.attn_sinks = (const float*)d_in[15];
    a.w_out = (const float*)d_in[16]; a.norm_ffn2 = (const float*)d_in[17]; a.ffn2_w_in = (const float*)d_in[18]; a.ffn2_w_out = (const float*)d_in[19]; a.final_norm = (const float*)d_in[20];
    a.out = (float*)d_out; a.ws = (unsigned char*)d_ws;
    void* args[] = {&a};
    hipError_t e = hipLaunchCooperativeKernel((const void*)fwd_megakernel, dim3(grid_blocks), dim3(NTHREADS), args, LDS_BYTES, stream);
    if (e != hipSuccess) fprintf(stderr, "kernel_launch: cooperative launch failed: %s (grid %d)\n", hipGetErrorString(e), grid_blocks);
}
```
